# Optimizing an MI355X kernel written in HIP

```python
import jax
import jax.numpy as jnp
from jax import lax
import numpy as np

D_MODEL = 2048
BATCH = 4
SEQ = 2048
DEPTH = 1

N_HEADS = 16
HEAD_DIM = 128
N_KV_GROUPS = 4
HEADS_PER_GROUP = N_HEADS // N_KV_GROUPS
ATTN_WIDTH = N_HEADS * HEAD_DIM
KV_WIDTH = N_KV_GROUPS * HEAD_DIM
CMP_BLOCK = 32
CMP_STRIDE = 16
CMP_HIDDEN = 256
SEL_BLOCK = 64
SEL_TOP_N = 8
SEL_QUERY_CHUNK = 64
WINDOW = 512
WIN_QBLOCK = 128
SCALE = HEAD_DIM ** -0.5
CONV_WIDTH = D_MODEL
CONV_K = 3
N_BRANCHES = 2
RMS_EPS = 1e-6
NEG_INF = -1e30
FORCED_SCORE = 1e4

IN_SPLIT_SIZES = (ATTN_WIDTH,
                  KV_WIDTH, KV_WIDTH,
                  KV_WIDTH, KV_WIDTH,
                  KV_WIDTH, KV_WIDTH,
                  3 * N_HEADS,
                  ATTN_WIDTH,
                  CONV_WIDTH, CONV_WIDTH, CONV_WIDTH,
                  CONV_WIDTH,
                  N_BRANCHES * D_MODEL)
N_IN = sum(IN_SPLIT_SIZES)

kernel_name = "nsa_shortconv_gated_hybrid"


def rmsnorm(x, g):
    xf = x.astype(jnp.float32)
    xf = xf * lax.rsqrt(jnp.mean(xf * xf, axis=-1, keepdims=True) + RMS_EPS)
    return xf.astype(x.dtype) * g


def masked_softmax(s, mask):
    s = jnp.where(mask, s.astype(jnp.float32), NEG_INF)
    p = jax.nn.softmax(s, axis=-1)
    return jnp.where(mask, p, 0.0)


def compress_blocks(kv, pe, w1, w2):
    B, S, G, Dh = kv.shape
    n_cmp = (S - CMP_BLOCK) // CMP_STRIDE + 1
    idx = np.arange(n_cmp)[:, None] * CMP_STRIDE + np.arange(CMP_BLOCK)[None, :]
    blocks = kv[:, idx] + pe[None, None, :, None, :]
    flat = blocks.transpose(0, 1, 3, 2, 4).reshape(B, n_cmp, G, CMP_BLOCK * Dh)
    return jax.nn.silu(flat @ w1) @ w2


def compressed_attention(q, kcb, vcb):
    S = q.shape[1]
    n_cmp = kcb.shape[1]
    t = np.arange(S)
    blk_end = np.arange(n_cmp) * CMP_STRIDE + CMP_BLOCK - 1
    mask = jnp.asarray(blk_end[None, :] <= t[:, None])
    s = jnp.einsum('bsghd,bngd->bghsn', q, kcb) * SCALE
    p = masked_softmax(s, mask)
    o = jnp.einsum('bghsn,bngd->bsghd', p.astype(vcb.dtype), vcb)
    return o, p


def select_blocks(p_cmp, S):
    n_cmp = p_cmp.shape[-1]
    n_slc = S // SEL_BLOCK
    c0 = np.arange(n_cmp)[:, None] * CMP_STRIDE
    s0 = np.arange(n_slc)[None, :] * SEL_BLOCK
    overlap = np.maximum(0, np.minimum(c0 + CMP_BLOCK, s0 + SEL_BLOCK) - np.maximum(c0, s0))
    agg = jnp.asarray(overlap / CMP_BLOCK, dtype=jnp.float32)
    imp = jnp.einsum('bghsn,nj->bgsj', p_cmp, agg)
    t = np.arange(S)[:, None]
    j = np.arange(n_slc)[None, :]
    cur = t // SEL_BLOCK
    causal = j * SEL_BLOCK <= t
    forced = ((j == 0) | (j == cur) | (j == cur - 1)) & causal
    imp = jnp.where(jnp.asarray(forced), FORCED_SCORE, imp)
    imp = jnp.where(jnp.asarray(causal), imp, -1.0)
    _, idx = lax.top_k(imp, min(SEL_TOP_N, n_slc))
    return idx


def selected_attention(q, k, v, idx):
    B, S, G, h, Dh = q.shape
    n_slc = S // SEL_BLOCK
    n_top = idx.shape[-1]
    nc = S // SEL_QUERY_CHUNK
    kb = k.reshape(B, n_slc, SEL_BLOCK, G, Dh).transpose(0, 3, 1, 2, 4)
    vb = v.reshape(B, n_slc, SEL_BLOCK, G, Dh).transpose(0, 3, 1, 2, 4)
    q_ch = q.reshape(B, nc, SEL_QUERY_CHUNK, G, h, Dh).transpose(1, 0, 2, 3, 4, 5)
    i_ch = idx.reshape(B, G, nc, SEL_QUERY_CHUNK, n_top).transpose(2, 0, 1, 3, 4)
    t_ch = jnp.arange(S, dtype=jnp.int32).reshape(nc, SEL_QUERY_CHUNK)
    bi = jnp.arange(B)[:, None, None, None]
    gi = jnp.arange(G)[None, :, None, None]
    offs = jnp.arange(SEL_BLOCK, dtype=jnp.int32)

    def chunk(args):
        qc, ic, tc = args
        kg = kb[bi, gi, ic]
        vg = vb[bi, gi, ic]
        s = jnp.einsum('bqghd,bgqnkd->bgqhnk', qc, kg) * SCALE
        kpos = ic[..., None] * SEL_BLOCK + offs
        mask = kpos <= tc[None, None, :, None, None]
        qn = qc.shape[1]
        s = s.reshape(B, G, qn, h, n_top * SEL_BLOCK)
        mask = mask.reshape(B, G, qn, 1, n_top * SEL_BLOCK)
        p = masked_softmax(s, mask).astype(vg.dtype)
        return jnp.einsum('bgqhm,bgqmd->bqghd', p, vg.reshape(B, G, qn, n_top * SEL_BLOCK, Dh))

    o = lax.map(chunk, (q_ch, i_ch, t_ch))
    return o.transpose(1, 0, 2, 3, 4, 5).reshape(B, S, G, h, Dh)


def window_attention(q, k, v):
    B, S, G, h, Dh = q.shape
    nqb = S // WIN_QBLOCK
    n_off = WINDOW // WIN_QBLOCK + 1
    kpad = jnp.pad(k, ((0, 0), (WINDOW, 0), (0, 0), (0, 0)))
    vpad = jnp.pad(v, ((0, 0), (WINDOW, 0), (0, 0), (0, 0)))
    k_band = jnp.concatenate([kpad[:, j * WIN_QBLOCK: j * WIN_QBLOCK + S].reshape(B, nqb, WIN_QBLOCK, G, Dh)
                              for j in range(n_off)], axis=2)
    v_band = jnp.concatenate([vpad[:, j * WIN_QBLOCK: j * WIN_QBLOCK + S].reshape(B, nqb, WIN_QBLOCK, G, Dh)
                              for j in range(n_off)], axis=2)
    kb_len = n_off * WIN_QBLOCK
    qpos = np.arange(nqb)[:, None, None] * WIN_QBLOCK + np.arange(WIN_QBLOCK)[None, :, None]
    kpos = np.arange(nqb)[:, None, None] * WIN_QBLOCK + np.arange(kb_len)[None, None, :] - WINDOW
    mask = jnp.asarray((kpos >= 0) & (kpos <= qpos) & (kpos > qpos - WINDOW))
    qb = q.reshape(B, nqb, WIN_QBLOCK, G, h, Dh)
    s = jnp.einsum('bnqghd,bnkgd->bnghqk', qb, k_band) * SCALE
    p = masked_softmax(s, mask[None, :, None, None]).astype(v.dtype)
    o = jnp.einsum('bnghqk,bnkgd->bnqghd', p, v_band)
    return o.reshape(B, S, G, h, Dh)


def short_conv(u, c_b, c_c, conv_w, conv_b):
    v = c_c * u
    y = lax.conv_general_dilated(v, conv_w[:, None, :].astype(v.dtype), window_strides=(1,),
                                 padding=[(CONV_K - 1, 0)],
                                 dimension_numbers=('NWC', 'WIO', 'NWC'),
                                 feature_group_count=CONV_WIDTH)
    return c_b * (y + conv_b)


def hybrid_layer(x, norm_g, w_in, b_in, pe_k, w1_k, w2_k, pe_v, w1_v, w2_v,
                 conv_w, conv_b, p_attn, p_conv, w_o):
    B, S, D = x.shape
    G, h, Dh = N_KV_GROUPS, HEADS_PER_GROUP, HEAD_DIM
    hn = rmsnorm(x, norm_g)
    proj = hn @ w_in + b_in
    cuts = np.cumsum(IN_SPLIT_SIZES)[:-1].tolist()
    (q, kc, vc, ks, vs, kw, vw, g_nsa, z_attn,
     u, c_c, c_b, z_conv, g_merge) = jnp.split(proj, cuts, axis=-1)
    q = q.reshape(B, S, G, h, Dh)
    kv = lambda a: a.reshape(B, S, G, Dh)
    kcb = compress_blocks(kv(kc), pe_k, w1_k, w2_k)
    vcb = compress_blocks(kv(vc), pe_v, w1_v, w2_v)
    o_cmp, p_cmp = compressed_attention(q, kcb, vcb)
    idx = select_blocks(p_cmp, S)
    o_sel = selected_attention(q, kv(ks), kv(vs), idx)
    o_win = window_attention(q, kv(kw), kv(vw))
    gb = jax.nn.sigmoid(g_nsa).reshape(B, S, 3, G, h, 1)
    o_attn = (gb[:, :, 0] * o_cmp + gb[:, :, 1] * o_sel + gb[:, :, 2] * o_win).reshape(B, S, ATTN_WIDTH)
    y_attn = (o_attn * jax.nn.silu(z_attn)) @ p_attn
    y_conv = (short_conv(u, c_b, c_c, conv_w, conv_b) * jax.nn.silu(z_conv)) @ p_conv
    gm = jax.nn.sigmoid(g_merge).reshape(B, S, N_BRANCHES, D)
    y = gm[:, :, 0] * y_attn + gm[:, :, 1] * y_conv
    return x + y @ w_o


def setup_inputs(seed: int = 0) -> dict:
    key = jax.random.key(seed)
    ks = jax.random.split(key, 17)
    f32 = jnp.float32
    L = DEPTH
    nrm = lambda k, shape, fan: jax.random.normal(k, shape, f32) * (fan ** -0.5)
    return {
        "x": jax.random.normal(ks[0], (BATCH, SEQ, D_MODEL), f32),
        "norm_g": 1.0 + 0.02 * jax.random.normal(ks[1], (L, D_MODEL), f32),
        "w_in": nrm(ks[2], (L, D_MODEL, N_IN), D_MODEL),
        "b_in": 0.02 * jax.random.normal(ks[3], (L, N_IN), f32),
        "cmp_pe_k": 0.1 * jax.random.normal(ks[4], (L, CMP_BLOCK, HEAD_DIM), f32),
        "cmp_w1_k": nrm(ks[5], (L, CMP_BLOCK * HEAD_DIM, CMP_HIDDEN), CMP_BLOCK * HEAD_DIM),
        "cmp_w2_k": nrm(ks[6], (L, CMP_HIDDEN, HEAD_DIM), CMP_HIDDEN),
        "cmp_pe_v": 0.1 * jax.random.normal(ks[7], (L, CMP_BLOCK, HEAD_DIM), f32),
        "cmp_w1_v": nrm(ks[8], (L, CMP_BLOCK * HEAD_DIM, CMP_HIDDEN), CMP_BLOCK * HEAD_DIM),
        "cmp_w2_v": nrm(ks[9], (L, CMP_HIDDEN, HEAD_DIM), CMP_HIDDEN),
        "conv_w": nrm(ks[10], (L, CONV_K, CONV_WIDTH), CONV_K),
        "conv_b": 0.02 * jax.random.normal(ks[11], (L, CONV_WIDTH), f32),
        "p_attn": nrm(ks[12], (L, ATTN_WIDTH, D_MODEL), ATTN_WIDTH),
        "p_conv": nrm(ks[13], (L, CONV_WIDTH, D_MODEL), CONV_WIDTH),
        "w_o": nrm(ks[14], (L, D_MODEL, D_MODEL), D_MODEL),
        "final_g": 1.0 + 0.02 * jax.random.normal(ks[15], (D_MODEL,), f32),
    }


def reference(x, norm_g, w_in, b_in, cmp_pe_k, cmp_w1_k, cmp_w2_k, cmp_pe_v, cmp_w1_v,
              cmp_w2_v, conv_w, conv_b, p_attn, p_conv, w_o, final_g):
    for l in range(DEPTH):
        x = hybrid_layer(x, norm_g[l], w_in[l], b_in[l], cmp_pe_k[l], cmp_w1_k[l], cmp_w2_k[l],
                         cmp_pe_v[l], cmp_w1_v[l], cmp_w2_v[l], conv_w[l], conv_b[l],
                         p_attn[l], p_conv[l], w_o[l])
    return rmsnorm(x, final_g)
```

```cpp
#include <hip/hip_runtime.h>
#include <hip/hip_cooperative_groups.h>
#include <cstdio>
#include <cstdint>
namespace cg = cooperative_groups;
namespace pg8 {
#define PG8_LAS __attribute__((address_space(3)))
typedef unsigned short bf16_t;
typedef short bf16x8 __attribute__((ext_vector_type(8)));
typedef float f32x4 __attribute__((ext_vector_type(4)));
typedef unsigned u32x4 __attribute__((ext_vector_type(4)));
constexpr int BM = 256, BK = 64, HALF = 128, HTB = HALF * BK * 2  , STAGE_BYTES = 8 * HTB, NXCD = 8, WGM = 8;

__host__ __device__ __forceinline__ int lds_byte(int r, int c) { const int st = (r >> 4) * 2 + (c >> 5), rr = r & 15, cc = c & 31, ob = rr * 64 + cc * 2; return st * 1024 + (ob ^ (((ob >> 9) & 1) << 5)); }
__host__ __device__ __forceinline__ void stage_rc(int b, int& R, int& C) { const int st = b / 1024, sb = b % 1024, swz = sb ^ (((sb >> 9) & 1) << 5); R = (st >> 1) * 16 + swz / 64; C = (st & 1) * 32 + (swz % 64) / 2; }
__host__ __device__ __forceinline__ int perm32(int rho) { const int n = rho >> 4, i = rho & 15; return 8 * (i >> 2) + 4 * n + (i & 3); }

struct Unit { int pm, pn; };
struct Gemm { const bf16_t* A; const bf16_t* Bt; int M, N, K; int lda = 0, ldb = 0; };

struct StaticOrder {
    int nM, nN, nwg, G, c;
    __host__ __device__ void init(int M, int N, int G_, int c_) { nM = M / BM; nN = N / BM; nwg = nM * nN; G = G_; c = c_; }
    __host__ __device__ bool next(int i, Unit& u) const {
        const long L = (long)i * G + c; if (L >= nwg) return false;
        int wgid = (int)L; { const int q = nwg / NXCD, r = nwg % NXCD, xcd = wgid % NXCD, off = wgid / NXCD; wgid = (xcd < r ? xcd * (q + 1) : r * (q + 1) + (xcd - r) * q) + off; }
        const int nig = WGM * nN, gid = wgid / nig, fm = gid * WGM, gsz = (nM - fm) < WGM ? (nM - fm) : WGM;
        u.pm = fm + ((wgid % nig) % gsz); u.pn = (wgid % nig) / gsz; return true;
    }
    __device__ __forceinline__ void a_ready(const Unit&) const {}
    __device__ __forceinline__ void done(const Unit&) const {}
};

__device__ __forceinline__ unsigned cvt_pk_bf16(float lo, float hi) { unsigned r; asm volatile("v_cvt_pk_bf16_f32 %0, %1, %2" : "=v"(r) : "v"(lo), "v"(hi)); return r; }
typedef float f32x2 __attribute__((ext_vector_type(2)));
typedef float f32x2_t __attribute__((ext_vector_type(2))); typedef __bf16 bf16x2_t __attribute__((ext_vector_type(2)));
__device__ __forceinline__ unsigned pk2(float lo, float hi) { f32x2_t v = {lo, hi}; bf16x2_t b = __builtin_convertvector(v, bf16x2_t); return __builtin_bit_cast(unsigned, b); }
__device__ __forceinline__ float bflo(unsigned w) { return __uint_as_float(w << 16); }
__device__ __forceinline__ float bfhi(unsigned w) { return __uint_as_float(w & 0xffff0000u); }
__device__ __forceinline__ float sigm_f(float v) { return __builtin_amdgcn_rcpf(1.f + __builtin_amdgcn_exp2f(-1.4426950408889634f * v)); }
__device__ __forceinline__ float silu_f(float v) { return v * sigm_f(v); }
constexpr int TOK = 8192, DM = 2048, NPAD = 19712;
constexpr float QSCALE = 0.08838834764831845f * 1.4426950408889634f;
constexpr size_t al256(size_t x) { return (x + 255) & ~(size_t)255; }
constexpr size_t SZ_TD = (size_t)TOK * DM * 2, SZ_KV = (size_t)TOK * 512 * 2, SZ_W = (size_t)DM * DM * 2;
constexpr size_t WS_CTL = 0;
constexpr size_t WS_WIN = 65536;
constexpr size_t WS_A1 = WS_WIN, WS_A2 = WS_WIN + SZ_TD;
constexpr size_t WS_HN = al256(WS_WIN + (size_t)NPAD * DM * 2);
constexpr size_t WS_Y = WS_HN;
constexpr size_t WS_PAT = WS_HN + SZ_TD, WS_PCT = WS_PAT + SZ_W, WS_WOT = WS_PCT + SZ_W;
constexpr size_t WS_W1K = WS_WOT + SZ_W, WS_W1V = WS_W1K + (size_t)512 * DM * 2;
constexpr size_t WS_BIAS = WS_W1V + (size_t)512 * DM * 2;
constexpr size_t WS_CPART = al256(WS_BIAS + (size_t)NPAD * 4);
constexpr size_t WS_Q = WS_CPART + 2 * 32 * 256 * 4;
constexpr size_t WS_KC = WS_Q + SZ_TD;
constexpr size_t WS_ZA = WS_KC + 6 * SZ_KV;
constexpr size_t WS_GM = WS_ZA + 5 * SZ_TD;
constexpr size_t WS_GN = WS_GM + 2 * SZ_TD;
constexpr size_t WS_PQK = WS_GN + (size_t)TOK * 256 * 2, WS_PQV = WS_PQK + (size_t)4 * 2048 * 512 * 2;
constexpr size_t WS_KCB = WS_PQV + (size_t)4 * 2048 * 512 * 2, WS_VCB = WS_KCB + 16 * 128 * 128 * 2;
constexpr size_t WS_PARK = WS_VCB + 16 * 128 * 128 * 2;
constexpr size_t WS_SLOTS = WS_PARK + (size_t)256 * 8 * 16384;
constexpr size_t WS_END = WS_SLOTS + (size_t)TOK * 32 * 4;
constexpr int CW_PANEL = 8192;

struct EpiIn {
    static constexpr bool PERM = true, AFTER_DRAIN = false;
    unsigned char* ws; const float* bias;
    __device__ __forceinline__ void load_bias(const Unit& u, int wc, int fq, f32x4 (&bv)[2][2]) const {
        const float* bp = bias + u.pn * BM + wc * 32 + 8 * fq;
#pragma unroll
        for (int bj = 0; bj < 2; ++bj)
#pragma unroll
            for (int n = 0; n < 2; ++n) bv[bj][n] = *(const f32x4*)(bp + bj * HALF + 4 * n);
    }
    __device__ __forceinline__ void operator()(const f32x4 (&acc)[2][2][4][2], const Unit& u, int wr, int wc, int fr, int fq) const {
        const int pn = u.pn;
        size_t off; int ldc, colt, act = 0; float sc = 1.f; bool kcl = false;
        if (pn < 8) { off = WS_Q; ldc = 2048; colt = pn * 256; sc = QSCALE; }
        else if (pn < 20) { const int s = (pn - 8) >> 1; off = WS_KC + (size_t)s * SZ_KV; ldc = 512; colt = ((pn - 8) & 1) * 256; kcl = true; }
        else if (pn < 60) { const int s = (pn - 20) >> 3; off = WS_ZA + (size_t)s * SZ_TD; ldc = 2048; colt = ((pn - 20) & 7) * 256; act = (s == 0 || s == 4) ? 1 : 0; }
        else if (pn < 76) { off = WS_GM; ldc = 4096; colt = (pn - 60) * 256; act = 2; }
        else { off = WS_GN; ldc = 256; colt = 0; act = 2; }
        bf16_t* base = (bf16_t*)(ws + off);
        const int row0 = u.pm * BM + wr * 64 + fr, cl = wc * 32 + 8 * fq, bcol0 = pn * BM + cl;
        if (pn >= 28 && pn < 60) {
            const bool bz = pn >= 44; bf16_t* ob = (bf16_t*)(ws + WS_ZA + (bz ? 2 : 1) * SZ_TD) + 128 * ((pn - 28) & 15) + cl;
#pragma unroll
            for (int ai = 0; ai < 2; ++ai)
#pragma unroll
                for (int m = 0; m < 4; ++m) { const int row = row0 + ai * HALF + m * 16;
                    f32x4 a0 = acc[ai][0][m][0], a1 = acc[ai][0][m][1], c0v = acc[ai][1][m][0], c1v = acc[ai][1][m][1];
                    if (bz) { c0v = (f32x4){silu_f(c0v[0]), silu_f(c0v[1]), silu_f(c0v[2]), silu_f(c0v[3])}; c1v = (f32x4){silu_f(c1v[0]), silu_f(c1v[1]), silu_f(c1v[2]), silu_f(c1v[3])}; }
                    a0 = a0 * c0v; a1 = a1 * c1v;
                    u32x4 w; w.x = pk2(a0[0], a0[1]); w.y = pk2(a0[2], a0[3]); w.z = pk2(a1[0], a1[1]); w.w = pk2(a1[2], a1[3]);
                    *(u32x4*)(ob + (size_t)row * 2048) = w; }
            return;
        }
        if (pn >= 60 && pn < 76) {
            bf16_t* ob = (bf16_t*)(ws + WS_GM) + 128 * (pn - 60) + cl;
#pragma unroll
            for (int ai = 0; ai < 2; ++ai)
#pragma unroll
                for (int m = 0; m < 4; ++m) { const int row = row0 + ai * HALF + m * 16;
                    const f32x4 a0 = acc[ai][0][m][0], a1 = acc[ai][0][m][1], c0v = acc[ai][1][m][0], c1v = acc[ai][1][m][1];
                    float r[8], g[8];
#pragma unroll
                    for (int k = 0; k < 4; ++k) { g[k] = fmaxf(sigm_f(c0v[k]), 1e-30f); g[4 + k] = fmaxf(sigm_f(c1v[k]), 1e-30f); r[k] = sigm_f(a0[k]) * __builtin_amdgcn_rcpf(g[k]); r[4 + k] = sigm_f(a1[k]) * __builtin_amdgcn_rcpf(g[4 + k]); }
                    u32x4 w; w.x = pk2(r[0], r[1]); w.y = pk2(r[2], r[3]); w.z = pk2(r[4], r[5]); w.w = pk2(r[6], r[7]);
                    *(u32x4*)(ob + (size_t)row * 2048) = w;
                    w.x = pk2(g[0], g[1]); w.y = pk2(g[2], g[3]); w.z = pk2(g[4], g[5]); w.w = pk2(g[6], g[7]);
                    *(u32x4*)(ob + (size_t)TOK * 2048 + (size_t)row * 2048) = w; }
            return;
        }
#pragma unroll
        for (int ai = 0; ai < 2; ++ai)
#pragma unroll
            for (int m = 0; m < 4; ++m) { const int row = row0 + ai * HALF + m * 16;
#pragma unroll
                for (int bj = 0; bj < 2; ++bj) { f32x4 v0 = acc[ai][bj][m][0], v1 = acc[ai][bj][m][1];
                    if (act == 1) { v0 = (f32x4){silu_f(v0[0]), silu_f(v0[1]), silu_f(v0[2]), silu_f(v0[3])}; v1 = (f32x4){silu_f(v1[0]), silu_f(v1[1]), silu_f(v1[2]), silu_f(v1[3])}; }
                    else if (act == 2) { v0 = (f32x4){sigm_f(v0[0]), sigm_f(v0[1]), sigm_f(v0[2]), sigm_f(v0[3])}; v1 = (f32x4){sigm_f(v1[0]), sigm_f(v1[1]), sigm_f(v1[2]), sigm_f(v1[3])}; }
                    v0 = v0 * sc; v1 = v1 * sc;
                    u32x4 w; w.x = pk2(v0[0], v0[1]); w.y = pk2(v0[2], v0[3]); w.z = pk2(v1[0], v1[1]); w.w = pk2(v1[2], v1[3]);
                    const int c = colt + cl + bj * HALF;
                    bf16_t* dst;
                    if (kcl) { const int b = row >> 11, s = row & 2047, g = c >> 7, d = c & 127; dst = base + ((size_t)((b * 4 + g) * 2048 + s)) * 128 + d; }
                    else dst = base + (size_t)row * ldc + c;
                    *(u32x4*)dst = w; } }
    }
};
struct EpiPlain {
    static constexpr bool PERM = true, AFTER_DRAIN = false;
    bf16_t* O; int ldc;
    __device__ __forceinline__ void operator()(const f32x4 (&acc)[2][2][4][2], const Unit& u, int wr, int wc, int fr, int fq) const {
        const int row0 = u.pm * BM + wr * 64 + fr, c0 = u.pn * BM + wc * 32 + 8 * fq;
#pragma unroll
        for (int ai = 0; ai < 2; ++ai)
#pragma unroll
            for (int m = 0; m < 4; ++m)
#pragma unroll
                for (int bj = 0; bj < 2; ++bj) { const f32x4 v0 = acc[ai][bj][m][0], v1 = acc[ai][bj][m][1];
                    u32x4 w; w.x = pk2(v0[0], v0[1]); w.y = pk2(v0[2], v0[3]); w.z = pk2(v1[0], v1[1]); w.w = pk2(v1[2], v1[3]);
                    *(u32x4*)(O + (size_t)(row0 + ai * HALF + m * 16) * ldc + c0 + bj * HALF) = w; }
    }
};
template <int MODE> struct EpiY {
    static constexpr bool PERM = true, AFTER_DRAIN = false;
    bf16_t* Y; const bf16_t* GM;
    __device__ __forceinline__ void operator()(const f32x4 (&acc)[2][2][4][2], const Unit& u, int wr, int wc, int fr, int fq) const {
        const int row0 = u.pm * BM + wr * 64 + fr, c0 = u.pn * BM + wc * 32 + 8 * fq;
#pragma unroll
        for (int ai = 0; ai < 2; ++ai)
#pragma unroll
            for (int m = 0; m < 4; ++m)
#pragma unroll
                for (int bj = 0; bj < 2; ++bj) { const size_t row = (size_t)(row0 + ai * HALF + m * 16); const int c = c0 + bj * HALF;
                    const u32x4 g = *(const u32x4*)(GM + row * 4096 + MODE * 2048 + c);
                    f32x4 v0 = acc[ai][bj][m][0], v1 = acc[ai][bj][m][1];
                    v0 = v0 * (f32x4){bflo(g.x), bfhi(g.x), bflo(g.y), bfhi(g.y)}; v1 = v1 * (f32x4){bflo(g.z), bfhi(g.z), bflo(g.w), bfhi(g.w)};
                    u32x4* yp = (u32x4*)(Y + row * 2048 + c);
                    if (MODE == 1) { const u32x4 y = *yp; v0 = v0 + (f32x4){bflo(y.x), bfhi(y.x), bflo(y.y), bfhi(y.y)}; v1 = v1 + (f32x4){bflo(y.z), bfhi(y.z), bflo(y.w), bfhi(y.w)}; }
                    u32x4 w; w.x = pk2(v0[0], v0[1]); w.y = pk2(v0[2], v0[3]); w.z = pk2(v1[0], v1[1]); w.w = pk2(v1[2], v1[3]);
                    *yp = w; }
    }
};
struct EpiYChain {
    static constexpr bool PERM = true, AFTER_DRAIN = false;
    bf16_t* Y; const bf16_t* GM;
    __device__ __forceinline__ bool keep_acc(const Unit& u) const { return u.pm < 32; }
    __device__ __forceinline__ void operator()(f32x4 (&acc)[2][2][4][2], const Unit& u, int wr, int wc, int fr, int fq) const {
        const bool first = u.pm < 32;
        const int row0 = (u.pm & 31) * BM + wr * 64 + fr, c0 = (u.pn & 7) * BM + wc * 32 + 8 * fq;
        u32x4 gv[2][4][2];
        const bf16_t* G = GM + (first ? (size_t)0 : (size_t)TOK * 2048);
#pragma unroll
        for (int ai = 0; ai < 2; ++ai)
#pragma unroll
            for (int m = 0; m < 4; ++m)
#pragma unroll
                for (int bj = 0; bj < 2; ++bj) gv[ai][m][bj] = __builtin_nontemporal_load((const u32x4*)(G + (size_t)(row0 + ai * HALF + m * 16) * 2048 + c0 + bj * HALF));
#pragma unroll
        for (int ai = 0; ai < 2; ++ai)
#pragma unroll
            for (int m = 0; m < 4; ++m)
#pragma unroll
                for (int bj = 0; bj < 2; ++bj) { const size_t row = (size_t)(row0 + ai * HALF + m * 16); const int c = c0 + bj * HALF;
                    const u32x4 g1 = gv[ai][m][bj];
                    const f32x4 s0 = {bflo(g1.x), bfhi(g1.x), bflo(g1.y), bfhi(g1.y)}, s1 = {bflo(g1.z), bfhi(g1.z), bflo(g1.w), bfhi(g1.w)};
                    if (first) { acc[ai][bj][m][0] = acc[ai][bj][m][0] * s0; acc[ai][bj][m][1] = acc[ai][bj][m][1] * s1; }
                    else { const f32x4 v0 = acc[ai][bj][m][0] * s0, v1 = acc[ai][bj][m][1] * s1;
                        u32x4 w; w.x = pk2(v0[0], v0[1]); w.y = pk2(v0[2], v0[3]); w.z = pk2(v1[0], v1[1]); w.w = pk2(v1[2], v1[3]);
                        *(u32x4*)(Y + row * 2048 + c) = w; } }
    }
};
struct EpiOutNorm {
    static constexpr bool PERM = true, AFTER_DRAIN = true;
    const float* x; float* out; const float* fg; float* slots; unsigned* cnt;
    __device__ __forceinline__ void fused(f32x4 (&acc)[2][2][4][2], const Unit& u, int wr, int wc, int fr, int fq, PG8_LAS unsigned char* lds, int wid, int lane) const {
        const int row0 = u.pm * BM + wr * 64 + fr, c0 = u.pn * BM + wc * 32 + 8 * fq;
#pragma unroll
        for (int ai = 0; ai < 2; ++ai)
#pragma unroll
            for (int m = 0; m < 4; ++m) { float s = 0.f;
#pragma unroll
                for (int bj = 0; bj < 2; ++bj) { const f32x4 a = acc[ai][bj][m][0], b = acc[ai][bj][m][1];
                    s += (a[0] * a[0] + a[1] * a[1]) + (a[2] * a[2] + a[3] * a[3]) + (b[0] * b[0] + b[1] * b[1]) + (b[2] * b[2] + b[3] * b[3]); }
                s += __shfl_xor(s, 16); s += __shfl_xor(s, 32);
                if (fq == 0) __hip_atomic_store(slots + (size_t)(row0 + ai * HALF + m * 16) * 32 + u.pn * 4 + wc, s, __ATOMIC_RELAXED, __HIP_MEMORY_SCOPE_AGENT); }
        asm volatile("s_waitcnt vmcnt(0)" ::: "memory");
        if (lane == 0) __hip_atomic_fetch_add(cnt + 64 * u.pm, 1u, __ATOMIC_RELAXED, __HIP_MEMORY_SCOPE_AGENT);
        if (wid == 0) {
            unsigned sp = 0;
            while ((unsigned)__builtin_amdgcn_readfirstlane(__hip_atomic_load(cnt + 64 * u.pm, __ATOMIC_RELAXED, __HIP_MEMORY_SCOPE_AGENT)) < 64u) { __builtin_amdgcn_s_sleep(2); if (++sp > (1u << 22)) break; }
            __builtin_amdgcn_fence(__ATOMIC_ACQUIRE, "agent");
        }
        asm volatile("s_waitcnt vmcnt(0) lgkmcnt(0)" ::: "memory"); __builtin_amdgcn_s_barrier(); asm volatile("" ::: "memory");
        PG8_LAS float* R = (PG8_LAS float*)lds;
        { const int t = wid * 64 + lane, r = t >> 1, hf = t & 1; const float* sl = slots + (size_t)(u.pm * BM + r) * 32 + hf * 16; float s = 0.f;
#pragma unroll
          for (int k = 0; k < 16; ++k) s += __hip_atomic_load(sl + k, __ATOMIC_RELAXED, __HIP_MEMORY_SCOPE_AGENT);
          s += __shfl_xor(s, 1);
          if (hf == 0) R[r] = 1.0f / sqrtf(s * (1.0f / 2048.0f) + 1e-6f); }
        asm volatile("s_waitcnt lgkmcnt(0)" ::: "memory"); __builtin_amdgcn_s_barrier(); asm volatile("" ::: "memory");
        f32x4 gv[2][2];
#pragma unroll
        for (int bj = 0; bj < 2; ++bj) { gv[bj][0] = *(const f32x4*)(fg + c0 + bj * HALF); gv[bj][1] = *(const f32x4*)(fg + c0 + bj * HALF + 4); }
#pragma unroll
        for (int ai = 0; ai < 2; ++ai)
#pragma unroll
            for (int m = 0; m < 4; ++m) { const int rl = ai * HALF + wr * 64 + m * 16 + fr; const float rs = R[rl];
#pragma unroll
                for (int bj = 0; bj < 2; ++bj) { const size_t o = (size_t)(u.pm * BM + rl) * 2048 + c0 + bj * HALF;
                    *(f32x4*)(out + o) = acc[ai][bj][m][0] * rs * gv[bj][0]; *(f32x4*)(out + o + 4) = acc[ai][bj][m][1] * rs * gv[bj][1]; } }
    }
};
template <class E> constexpr bool epi_has_bias = false;
template <> constexpr bool epi_has_bias<EpiIn> = true;
template <class E> __device__ __forceinline__ auto keep_acc_of(const E& e, const Unit& u, int) -> decltype(e.keep_acc(u)) { return e.keep_acc(u); }
template <class E> __device__ __forceinline__ bool keep_acc_of(const E&, const Unit&, long) { return false; }
template <class Epi, class Sched, bool ALIGN_EPI = false, bool SP2 = false>
__device__ __forceinline__ void gemm_phase(PG8_LAS unsigned char* lds, const Gemm g, const Sched& S, const Epi& E, const f32x4 (*acc0)[2][4][2] = nullptr) {
    const int tid = threadIdx.x, wid = __builtin_amdgcn_readfirstlane(tid >> 6), lane = tid & 63, wr = wid >> 2, wc = wid & 3, fr = lane & 15, fq = lane >> 4;
    const int K = g.K, nt = K / BK; const int lda = g.lda ? g.lda : K, ldb = g.ldb ? g.ldb : K;
    unsigned voffA[2], voffB[2];
#pragma unroll
    for (int i = 0; i < 2; ++i) { int R, C; stage_rc(tid * 16 + i * 8192, R, C); const int Rb = Epi::PERM ? ((R & ~31) + perm32(R & 31)) : R;
        voffA[i] = (unsigned)(R * lda + C) * 2u; voffB[i] = (unsigned)(Rb * ldb + C) * 2u; }
    const size_t kstep = (size_t)(BK * 2);
    const size_t hstepA = (size_t)HALF * lda * 2, hstepB = (size_t)HALF * ldb * 2;
    const size_t tstepA = 2 * hstepA, tstepB = 2 * hstepB;
    const unsigned ldsw = (unsigned)wid * 1024u;
    const int aoff = lds_byte(wr * 64 + fr, fq * 8), boff = lds_byte(wc * 32 + fr, fq * 8);
#define PG8_SA(b, h) (((b) * 2 + (h)) * HTB)
#define PG8_SB(b, h) ((4 + (b) * 2 + (h)) * HTB)
#define PG8_STAGE(bufoff, gbase, voff) do { _Pragma("unroll") for (int _i = 0; _i < 2; ++_i) \
        __builtin_amdgcn_global_load_lds((const unsigned*)((const char*)(gbase) + (voff)[_i]), (PG8_LAS unsigned*)(lds + (bufoff) + ldsw + _i * 8192), 16, 0, 0); } while (0)
#define PG8_LDA(dst, b, h) do { _Pragma("unroll") for (int m = 0; m < 4; ++m) _Pragma("unroll") for (int k = 0; k < 2; ++k) dst[m][k] = *(const PG8_LAS bf16x8*)(lds + PG8_SA(b, h) + aoff + m * 2048 + k * 1024); } while (0)
#define PG8_LDB(dst, b, h) do { _Pragma("unroll") for (int n = 0; n < 2; ++n) _Pragma("unroll") for (int k = 0; k < 2; ++k) dst[n][k] = *(const PG8_LAS bf16x8*)(lds + PG8_SB(b, h) + boff + n * 2048 + k * 1024); } while (0)
#define PG8_MMA(ai, bj, At, Bt) do { __builtin_amdgcn_s_setprio(1); _Pragma("unroll") for (int m = 0; m < 4; ++m) _Pragma("unroll") for (int n = 0; n < 2; ++n) _Pragma("unroll") for (int k = 0; k < 2; ++k) \
        acc[ai][bj][m][n] = __builtin_amdgcn_mfma_f32_16x16x32_bf16(Bt[n][k], At[m][k], acc[ai][bj][m][n], 0, 0, 0); __builtin_amdgcn_s_setprio(0); } while (0)
#define PG8_WAIT_V(n) asm volatile("s_waitcnt vmcnt(" #n ")" ::: "memory")
#define PG8_WAIT_L(n) asm volatile("s_waitcnt lgkmcnt(" #n ")" ::: "memory")
#define PG8_BAR __builtin_amdgcn_s_barrier()
#define PG8_SCHED __builtin_amdgcn_sched_barrier(0)
    Unit cur, nxt; int ui = 0;
    if (!S.next(0, cur)) return;
    f32x4 acc[2][2][4][2];
#pragma unroll
    for (int a = 0; a < 2; ++a)
#pragma unroll
        for (int b = 0; b < 2; ++b)
#pragma unroll
            for (int m = 0; m < 4; ++m)
#pragma unroll
                for (int n = 0; n < 2; ++n) acc[a][b][m][n] = acc0 ? acc0[a][b][m][n] : (f32x4){0.f, 0.f, 0.f, 0.f};
    f32x4 bnx[2][2];
    if constexpr (epi_has_bias<Epi>) { E.load_bias(cur, wc, fq, bnx);
#pragma unroll
        for (int a = 0; a < 2; ++a)
#pragma unroll
            for (int b = 0; b < 2; ++b)
#pragma unroll
                for (int m = 0; m < 4; ++m)
#pragma unroll
                    for (int n = 0; n < 2; ++n) acc[a][b][m][n] = bnx[b][n]; }
    bf16x8 At[4][2], B0[2][2], B1[2][2];
    const char* cA = (const char*)g.A + (size_t)cur.pm * tstepA; const char* cB = (const char*)g.Bt + (size_t)cur.pn * tstepB;
    S.a_ready(cur);
    if constexpr (SP2) {
        PG8_STAGE(PG8_SB(0, 0), cB, voffB); PG8_STAGE(PG8_SB(0, 1), cB + hstepB, voffB); PG8_STAGE(PG8_SA(0, 0), cA, voffA); PG8_STAGE(PG8_SA(0, 1), cA + hstepA, voffA);
        if (wr == 1) PG8_BAR;
        PG8_WAIT_V(2); PG8_BAR;
        PG8_STAGE(PG8_SB(1, 0), cB + kstep, voffB); PG8_STAGE(PG8_SA(1, 0), cA + kstep, voffA); PG8_STAGE(PG8_SB(1, 1), cB + hstepB + kstep, voffB);
        PG8_WAIT_V(6); PG8_BAR;
    } else {
        PG8_STAGE(PG8_SB(0, 0), cB, voffB); PG8_STAGE(PG8_SA(0, 0), cA, voffA); PG8_STAGE(PG8_SB(0, 1), cB + hstepB, voffB); PG8_STAGE(PG8_SA(0, 1), cA + hstepA, voffA);
        if (wr == 1) PG8_BAR;
        PG8_WAIT_V(4); PG8_BAR;
        PG8_STAGE(PG8_SB(1, 0), cB + kstep, voffB); PG8_STAGE(PG8_SA(1, 0), cA + kstep, voffA); PG8_STAGE(PG8_SB(1, 1), cB + hstepB + kstep, voffB);
        PG8_WAIT_V(6); PG8_BAR;
    }
    for (;;) {
        const bool has_next = S.next(ui + 1, nxt);
        const char* nA = has_next ? (const char*)g.A + (size_t)nxt.pm * tstepA : cA; const char* nB = has_next ? (const char*)g.Bt + (size_t)nxt.pn * tstepB : cB;
        for (int t = 0; t < nt; t += 2) {
            const bool last = (t == nt - 2);
            const char* a1 = cA + (size_t)(t + 1) * kstep;
            const char* a2 = last ? nA : cA + (size_t)(t + 2) * kstep; const char* b2 = last ? nB : cB + (size_t)(t + 2) * kstep;
            const char* a3 = a2 + kstep; const char* b3 = b2 + kstep;
            if (last && has_next) S.a_ready(nxt);
            if constexpr (SP2) {
            PG8_LDB(B0, 0, 0); PG8_LDB(B1, 0, 1); PG8_SCHED; PG8_LDA(At, 0, 0); PG8_STAGE(PG8_SA(1, 1), a1 + hstepA, voffA);
            PG8_WAIT_V(8); PG8_WAIT_L(0); PG8_BAR; PG8_MMA(0, 0, At, B0); PG8_MMA(0, 1, At, B1); PG8_BAR; PG8_SCHED;
            PG8_LDA(At, 0, 1); PG8_STAGE(PG8_SB(0, 0), b2, voffB); PG8_STAGE(PG8_SB(0, 1), b2 + hstepB, voffB); PG8_STAGE(PG8_SA(0, 0), a2, voffA);
            PG8_WAIT_V(8); PG8_WAIT_L(0); PG8_BAR; PG8_MMA(1, 0, At, B0); PG8_MMA(1, 1, At, B1); PG8_BAR; PG8_SCHED;
            PG8_LDB(B0, 1, 0); PG8_LDB(B1, 1, 1); PG8_SCHED; PG8_LDA(At, 1, 0); PG8_STAGE(PG8_SA(0, 1), a2 + hstepA, voffA);
            PG8_WAIT_V(8); PG8_WAIT_L(0); PG8_BAR; PG8_MMA(0, 0, At, B0); PG8_MMA(0, 1, At, B1); PG8_BAR; PG8_SCHED;
            PG8_LDA(At, 1, 1); PG8_STAGE(PG8_SB(1, 0), b3, voffB); PG8_STAGE(PG8_SB(1, 1), b3 + hstepB, voffB); PG8_STAGE(PG8_SA(1, 0), a3, voffA);
            PG8_WAIT_V(8); PG8_WAIT_L(0); PG8_BAR; PG8_MMA(1, 0, At, B0); PG8_MMA(1, 1, At, B1); PG8_BAR; PG8_SCHED;
            } else {
            PG8_LDB(B0, 0, 0); PG8_SCHED; PG8_LDA(At, 0, 0); PG8_STAGE(PG8_SA(1, 1), a1 + hstepA, voffA);
            PG8_WAIT_L(8); PG8_BAR; PG8_WAIT_L(0); PG8_MMA(0, 0, At, B0); PG8_BAR; PG8_SCHED;
            PG8_LDB(B1, 0, 1); PG8_STAGE(PG8_SB(0, 0), b2, voffB);
            PG8_BAR; PG8_WAIT_L(0); PG8_MMA(0, 1, At, B1); PG8_BAR;
            PG8_LDA(At, 0, 1); PG8_STAGE(PG8_SA(0, 0), a2, voffA);
            PG8_BAR; PG8_WAIT_L(0); PG8_MMA(1, 0, At, B0); PG8_BAR; PG8_SCHED;
            PG8_STAGE(PG8_SB(0, 1), b2 + hstepB, voffB);
            PG8_WAIT_V(6); PG8_BAR; PG8_MMA(1, 1, At, B1); PG8_BAR;
            PG8_LDB(B0, 1, 0); PG8_SCHED; PG8_LDA(At, 1, 0); PG8_STAGE(PG8_SA(0, 1), a2 + hstepA, voffA);
            PG8_WAIT_L(8); PG8_BAR; PG8_WAIT_L(0); PG8_MMA(0, 0, At, B0); PG8_BAR; PG8_SCHED;
            PG8_LDB(B1, 1, 1); PG8_STAGE(PG8_SB(1, 0), b3, voffB);
            PG8_BAR; PG8_WAIT_L(0); PG8_MMA(0, 1, At, B1); PG8_BAR;
            PG8_LDA(At, 1, 1); PG8_STAGE(PG8_SA(1, 0), a3, voffA);
            PG8_BAR; PG8_WAIT_L(0); PG8_MMA(1, 0, At, B0); PG8_BAR; PG8_SCHED;
            PG8_STAGE(PG8_SB(1, 1), b3 + hstepB, voffB);
            PG8_WAIT_V(6); PG8_BAR; PG8_MMA(1, 1, At, B1); PG8_BAR;
            }
        }
        if constexpr (ALIGN_EPI) { if (wr == 0) PG8_BAR; }
        if constexpr (epi_has_bias<Epi>) { if (has_next) E.load_bias(nxt, wc, fq, bnx); }
        if constexpr (!Epi::AFTER_DRAIN) { E(acc, cur, wr, wc, fr, fq); S.done(cur); }
        if (!has_next) break;
        if (!keep_acc_of(E, cur, 0)) {
#pragma unroll
        for (int a = 0; a < 2; ++a)
#pragma unroll
            for (int b = 0; b < 2; ++b)
#pragma unroll
                for (int m = 0; m < 4; ++m)
#pragma unroll
                    for (int n = 0; n < 2; ++n) { if constexpr (epi_has_bias<Epi>) acc[a][b][m][n] = bnx[b][n]; else acc[a][b][m][n] = (f32x4){0.f, 0.f, 0.f, 0.f}; }
        }
        cur = nxt; cA = nA; cB = nB; ++ui;
        if constexpr (ALIGN_EPI) { if (wr == 1) PG8_BAR; }
    }
    PG8_WAIT_V(0);
    if constexpr (!ALIGN_EPI) { if (wr == 0) PG8_BAR; }
    PG8_BAR;
    if constexpr (Epi::AFTER_DRAIN) { E.fused(acc, cur, wr, wc, fr, fq, lds, wid, lane); S.done(cur); }
#undef PG8_SA
#undef PG8_SB
#undef PG8_STAGE
#undef PG8_LDA
#undef PG8_LDB
#undef PG8_MMA
#undef PG8_WAIT_V
#undef PG8_WAIT_L
#undef PG8_BAR
#undef PG8_SCHED
}
}

#define LAS __attribute__((address_space(3)))
#define DI __device__ __forceinline__
using pg8::bf16_t; using pg8::pk2; using pg8::bflo; using pg8::bfhi; using pg8::silu_f;
using pg8::TOK; using pg8::DM; using pg8::NPAD;
typedef short bf16x8 __attribute__((ext_vector_type(8)));
typedef short s16x4 __attribute__((ext_vector_type(4)));
typedef short v4i16_t __attribute__((ext_vector_type(4)));
typedef float f32x16 __attribute__((ext_vector_type(16)));
typedef float f32x4 __attribute__((ext_vector_type(4)));
typedef unsigned u32x4 __attribute__((ext_vector_type(4)));
typedef unsigned u32x2 __attribute__((ext_vector_type(2)));
#define LDS_WAIT() asm volatile("s_waitcnt lgkmcnt(0)" ::: "memory")
DI float bf2f(bf16_t v) { return __uint_as_float((unsigned)v << 16); }
DI float wave_sum(float v) {
#pragma unroll
    for (int o = 1; o < 64; o <<= 1) v += __shfl_xor(v, o);
    return v;
}
DI float ex2(float v) { return __builtin_amdgcn_exp2f(v); }

DI int win_src_col(int n) {
    if (n < 5120) return n;
    if (n < 7168) return n + 48;
    if (n < 15360) { const int t = (n - 7168) >> 8, j = (n - 7168) & 255, hf = j >> 7, ch = 128 * (t & 15) + (j & 127); return (t < 16 ? (hf ? 9264 : 7216) : (hf ? 13360 : 11312)) + ch; }
    if (n < 19456) { const int t = (n - 15360) >> 8, j = (n - 15360) & 255; return 15408 + ((j >> 7) ? 2048 : 0) + 128 * t + (j & 127); }
    return n < 19504 ? n - 14336 : -1; }
DI void tr_item(const float* __restrict__ W, int Nsrc, int srccol4, bf16_t* WT, int Kdst, int n0dst, int k0, LAS float* scr, int lane) {
    const int c4 = 4 * (lane & 15);
    f32x4 v[16];
#pragma unroll
    for (int i = 0; i < 16; ++i) { v[i] = (f32x4){0.f, 0.f, 0.f, 0.f}; if (srccol4 >= 0) v[i] = __builtin_nontemporal_load((const f32x4*)(W + (size_t)(k0 + 4 * i + (lane >> 4)) * Nsrc + srccol4)); }
#pragma unroll
    for (int i = 0; i < 16; ++i) { LAS float* d = scr + (4 * i + (lane >> 4)) * 65 + c4; d[0] = v[i].x; d[1] = v[i].y; d[2] = v[i].z; d[3] = v[i].w; }
    LDS_WAIT();
    const int c = lane & 7;
#pragma unroll
    for (int x = 0; x < 8; ++x) { const int n = 8 * x + (lane >> 3); const LAS float* s = scr + (8 * c) * 65 + n;
        u32x4 o; o.x = pk2(s[0 * 65], s[1 * 65]); o.y = pk2(s[2 * 65], s[3 * 65]); o.z = pk2(s[4 * 65], s[5 * 65]); o.w = pk2(s[6 * 65], s[7 * 65]);
        *(u32x4*)(WT + (size_t)(n0dst + n) * Kdst + k0 + 8 * c) = o; }
    LDS_WAIT();
}
struct Args { const float* in[16]; float* out; unsigned char* ws; int ph_lo, ph_hi, ph_rep, pad; };

template <int PART>
DI void p0_phase(LAS unsigned char* lds, const Args& a, int fi, int nf, int tid, int lane, int wave) {
    unsigned char* ws = a.ws;
    LAS float* scr = (LAS float*)(lds + wave * 16640);
    const int gw = fi * 8 + wave, NGW = nf * 8;
    constexpr int I_WIN = 32 * 308, I_SQ = 32 * 32, I_W1 = 256;
    const int l4 = 4 * (lane & 15);
    if (PART == 0) {
        for (int r = gw; r < I_WIN; r += NGW) { const int kb = r & 31, nb = r >> 5;
            tr_item(a.in[2], 19504, win_src_col(nb * 64 + l4), (bf16_t*)(ws + pg8::WS_WIN), 2048, nb * 64, kb * 64, scr, lane); }
        for (int m = gw; m < TOK; m += NGW) {
            const f32x4* xr = (const f32x4*)(a.in[0] + (size_t)m * DM) + lane; const f32x4* gr = (const f32x4*)a.in[1] + lane;
            f32x4 v[8]; float s = 0.f;
#pragma unroll
            for (int j = 0; j < 8; ++j) { v[j] = __builtin_nontemporal_load(xr + 64 * j); s += (v[j].x * v[j].x + v[j].y * v[j].y) + (v[j].z * v[j].z + v[j].w * v[j].w); }
            const float rs = 1.0f / sqrtf(wave_sum(s) * (1.f / DM) + 1e-6f);
            u32x2* o8 = (u32x2*)((bf16_t*)(ws + pg8::WS_HN) + (size_t)m * DM) + lane;
#pragma unroll
            for (int j = 0; j < 8; ++j) { const f32x4 g = gr[64 * j]; u32x2 w; w.x = pk2(v[j].x * rs * g.x, v[j].y * rs * g.y); w.y = pk2(v[j].z * rs * g.z, v[j].w * rs * g.w); o8[64 * j] = w; }
        }
        { float* bp = (float*)(ws + pg8::WS_BIAS);
          for (int n = fi * 512 + tid; n < NPAD; n += nf * 512) { const int sc = win_src_col(n); bp[n] = sc >= 0 ? a.in[3][sc] : 0.f; } }
    } else {
        for (int r0 = gw; r0 < 3 * I_SQ + 2 * I_W1; r0 += NGW) { int r = r0;
            if (r < 3 * I_SQ) { const int w = r / I_SQ, r2 = r % I_SQ, kb = r2 & 31, nb = r2 >> 5;
                tr_item(a.in[12 + w], 2048, nb * 64 + l4, (bf16_t*)(ws + pg8::WS_PAT + (size_t)w * pg8::SZ_W), 2048, nb * 64, kb * 64, scr, lane); continue; }
            r -= 3 * I_SQ;
            { const int which = r / I_W1, r2 = r % I_W1, half = r2 / 128, r3 = r2 % 128, kb = r3 & 31, nb = r3 >> 5;
              tr_item(a.in[which ? 8 : 5] + (size_t)half * 2048 * 256, 256, nb * 64 + l4, (bf16_t*)(ws + (which ? pg8::WS_W1V : pg8::WS_W1K)), 2048, half * 256 + nb * 64, kb * 64, scr, lane); } }
        for (int job = fi * 2 + (tid >> 8); job < 64; job += nf * 2) { const int which = job >> 5, chunk = job & 31, j = tid & 255;
            const float* pe = a.in[which ? 7 : 4] + chunk * 128; const float* w1 = a.in[which ? 8 : 5] + (size_t)chunk * 128 * 256 + j; float s = 0.f;
#pragma unroll 32
            for (int r = 0; r < 128; ++r) s += pe[r] * w1[(size_t)r * 256];
            ((float*)(ws + pg8::WS_CPART))[(which * 32 + chunk) * 256 + j] = s; }
    }
}

DI void conv_run(unsigned char* ws, const float* cw, const float* cbias, int run, int tid) {
    const int cg8 = tid & 255, t0 = run * 8, ch = cg8 * 8;
    const bf16_t* V = (const bf16_t*)(ws + pg8::WS_ZA + 1 * pg8::SZ_TD); const bf16_t* GT = (const bf16_t*)(ws + pg8::WS_ZA + 2 * pg8::SZ_TD);
    bf16_t* A2 = (bf16_t*)(ws + pg8::WS_A2);
    float w0[8], w1[8], w2[8], bb[8], v1[8], v2[8];
#pragma unroll
    for (int k = 0; k < 8; ++k) { w0[k] = cw[ch + k]; w1[k] = cw[2048 + ch + k]; w2[k] = cw[4096 + ch + k]; bb[k] = cbias[ch + k]; v1[k] = 0.f; v2[k] = 0.f; }
    auto unpack = [](const u32x4 w, float (&f)[8]) { f[0] = bflo(w.x); f[1] = bfhi(w.x); f[2] = bflo(w.y); f[3] = bfhi(w.y); f[4] = bflo(w.z); f[5] = bfhi(w.z); f[6] = bflo(w.w); f[7] = bfhi(w.w); };
    u32x4 vv[8], gv[8];
#pragma unroll
    for (int tt = 0; tt < 8; ++tt) { const size_t o = (size_t)(t0 + tt) * DM + ch; vv[tt] = *(const u32x4*)(V + o); gv[tt] = __builtin_nontemporal_load((const u32x4*)(GT + o)); }
    if ((t0 & 2047) != 0) { unpack(*(const u32x4*)(V + (size_t)(t0 - 2) * DM + ch), v2); unpack(*(const u32x4*)(V + (size_t)(t0 - 1) * DM + ch), v1); }
#pragma unroll
    for (int tt = 0; tt < 8; ++tt) { const size_t o = (size_t)(t0 + tt) * DM + ch;
        float v[8], g[8], r[8];
        unpack(vv[tt], v); unpack(gv[tt], g);
#pragma unroll
        for (int k = 0; k < 8; ++k) { const float y = w0[k] * v2[k] + w1[k] * v1[k] + w2[k] * v[k] + bb[k]; r[k] = g[k] * y; v2[k] = v1[k]; v1[k] = v[k]; }
        u32x4 w; w.x = pk2(r[0], r[1]); w.y = pk2(r[2], r[3]); w.z = pk2(r[4], r[5]); w.w = pk2(r[6], r[7]);
        *(u32x4*)(A2 + o) = w; }
}

DI void p3_phase(LAS unsigned char* lds, unsigned char* ws, const float* w2k, const float* w2v, int bx, int G, int tid) {
    LAS float* cst = (LAS float*)lds;
    LAS float* hid = cst + 256;
    for (int item = bx; item < 256; item += G) {
        const int which = item >> 7, rem = item & 127, bg = rem >> 3, n0 = (rem & 7) * 16;
        if (tid < 256) { const float* cp = (const float*)(ws + pg8::WS_CPART) + which * 32 * 256 + tid; float s = 0.f;
#pragma unroll 8
            for (int k = 0; k < 32; ++k) s += cp[k * 256];
            cst[tid] = s; }
        __syncthreads();
        const bf16_t* PQ = (const bf16_t*)(ws + (which ? pg8::WS_PQV : pg8::WS_PQK));
#pragma unroll
        for (int x = 0; x < 8; ++x) { const int e = tid + 512 * x, r = e >> 8, j = e & 255, n = n0 + r; float hv = 0.f;
            if (n < 127) { float s = cst[j];
#pragma unroll
                for (int sp = 0; sp < 4; ++sp) s += bf2f(PQ[(size_t)sp * 2048 * 512 + (size_t)(bg * 128 + n) * 512 + j]) + bf2f(PQ[(size_t)sp * 2048 * 512 + (size_t)(bg * 128 + n + 1) * 512 + 256 + j]);
                hv = silu_f(s); }
            hid[j * 16 + r] = hv; }
        __syncthreads();
        const int d = tid & 127, rg = tid >> 7; const float* w2 = (which ? w2v : w2k) + d; f32x4 acc = {0.f, 0.f, 0.f, 0.f};
#pragma unroll 16
        for (int j = 0; j < 256; ++j) acc += *(const LAS f32x4*)(hid + j * 16 + 4 * rg) * w2[j * 128];
        bf16_t* ob = (bf16_t*)(ws + (which ? pg8::WS_VCB : pg8::WS_KCB)) + (size_t)(bg * 128 + n0 + 4 * rg) * 128 + d;
#pragma unroll
        for (int k = 0; k < 4; ++k) ob[k * 128] = (bf16_t)(pk2((n0 + 4 * rg + k) < 127 ? acc[k] : 0.f, 0.f) & 0xffffu);
        __syncthreads();
    }
}

DI void p8_phase(float* out, const float* fg, int vcu, int G, int lane, int wave) {
    for (int m = vcu * 8 + wave; m < TOK; m += G * 8) {
        f32x4* xr = (f32x4*)(out + (size_t)m * DM) + lane; const f32x4* gr = (const f32x4*)fg + lane;
        f32x4 v[8]; float s = 0.f;
#pragma unroll
        for (int j = 0; j < 8; ++j) { v[j] = xr[64 * j]; s += (v[j].x * v[j].x + v[j].y * v[j].y) + (v[j].z * v[j].z + v[j].w * v[j].w); }
        const float rs = 1.0f / sqrtf(wave_sum(s) * (1.f / DM) + 1e-6f);
#pragma unroll
        for (int j = 0; j < 8; ++j) xr[64 * j] = v[j] * rs * gr[64 * j];
    }
}
namespace att {
constexpr int KP = 272, VP = 320, KBUF = 64 * KP, VBUF = 64 * VP;
constexpr int L_K = 0, L_V = 2 * KBUF, L_IMPH = L_V + 2 * VBUF, L_IMP = L_IMPH + 4 * 64 * 33 * 4  , L_PARK = L_IMPH  , L_MASK = 146688, L_END = L_MASK + 256;
static_assert(L_IMP + 8192 <= L_PARK + 65536 && L_PARK + 65536 <= L_MASK, "attention LDS map");
constexpr float NEG = -1e30f;
DI float xhalf(float v) { const auto rr = __builtin_amdgcn_permlane32_swap(__float_as_uint(v), __float_as_uint(v), false, false); return __uint_as_float((threadIdx.x & 32) ? rr[0] : rr[1]); }
DI float fadd_s(float a, float b) { float r; asm("v_add_f32_e32 %0, %1, %2" : "=v"(r) : "v"(a), "v"(b)); return r; }
DI int crow(int i, int h) { return (i & 3) + 8 * (i >> 2) + 4 * h; }
#define MFMA32(a, b, c) __builtin_amdgcn_mfma_f32_32x32x16_bf16((a), (b), (c), 0, 0, 0)
DI s16x4 vtr(const LAS unsigned char* p) { return __builtin_bit_cast(s16x4, __builtin_amdgcn_ds_read_tr16_b64_v4i16((LAS v4i16_t*)p)); }
DI bf16x8 pack8(const f32x16& p, int s8) {
    u32x4 w; w.x = pk2(p[s8 + 0], p[s8 + 1]); w.y = pk2(p[s8 + 2], p[s8 + 3]); w.z = pk2(p[s8 + 4], p[s8 + 5]); w.w = pk2(p[s8 + 6], p[s8 + 7]); return __builtin_bit_cast(bf16x8, w); }
DI void pv_step(f32x16 (&o)[4], const LAS unsigned char* vb, const bf16x8 pk) {
#pragma unroll
    for (int d = 0; d < 4; ++d) { const s16x4 lo = vtr(vb + d * 64), hi = vtr(vb + d * 64 + 8 * VP);
        const bf16x8 vf = __builtin_shufflevector(lo, hi, 0, 1, 2, 3, 4, 5, 6, 7); o[d] = MFMA32(vf, pk, o[d]); }
    __builtin_amdgcn_sched_barrier(0);
}

DI void pv_nobar(f32x16 (&o)[4], const LAS unsigned char* vb, const bf16x8 pk) {
#pragma unroll
    for (int d = 0; d < 4; ++d) { const s16x4 lo = vtr(vb + d * 64), hi = vtr(vb + d * 64 + 8 * VP);
        const bf16x8 vf = __builtin_shufflevector(lo, hi, 0, 1, 2, 3, 4, 5, 6, 7); o[d] = MFMA32(vf, pk, o[d]); }
}
template <int BR>
DI void flash(LAS unsigned char* lds, const bf16_t* __restrict__ Kg, const bf16_t* __restrict__ Vg, int c, const bf16x8 (&q)[8], f32x16 (&o)[4], float& lsum, unsigned selmask, int tokoff, int lane, int tid, u32x4& fk0, u32x4& fk1, u32x4& fv0, u32x4& fv1, const bf16_t* __restrict__ Kn, const bf16_t* __restrict__ Vn) {
    const int h = lane >> 5, r32 = lane & 31;
    const int jlo = (BR == 1) ? 0 : (c > 8 ? c - 8 : 0);
    const int ntiles = c - jlo + 1;
    const int key0 = tid >> 4, part = tid & 15;
    u32x4 r0, r1, r2, r3;
    const unsigned goff = (unsigned)tid * 16u;
    const unsigned kdo = (unsigned)(key0 * KP + part * 16), vdo = (unsigned)(key0 * VP + part * 16);
#define GLOADX(P, j) do { const char* p_ = (const char*)(P) + (size_t)(j) * 16384; r0 = *(const u32x4*)(p_ + goff); r1 = *(const u32x4*)(p_ + 8192 + goff); } while (0)
#define LSTOREK(buf) do { LAS unsigned char* d_ = lds + L_K + (buf) * KBUF + kdo; *(LAS u32x4*)d_ = r0; *(LAS u32x4*)(d_ + 32 * KP) = r1; } while (0)
#define GLOADV(P, j) do { const char* p_ = (const char*)(P) + (size_t)(j) * 16384; r2 = *(const u32x4*)(p_ + goff); r3 = *(const u32x4*)(p_ + 8192 + goff); } while (0)
#define LSTOREV(buf) do { LAS unsigned char* d_ = lds + L_V + (buf) * VBUF + vdo; *(LAS u32x4*)d_ = r2; *(LAS u32x4*)(d_ + 32 * VP) = r3; } while (0)
#define KRD(dst, kb_, pr) do { dst[0] = *(const LAS bf16x8*)((kb_) + (2 * (pr)) * 32); dst[1] = *(const LAS bf16x8*)((kb_) + 32 * KP + (2 * (pr)) * 32); \
        dst[2] = *(const LAS bf16x8*)((kb_) + (2 * (pr) + 1) * 32); dst[3] = *(const LAS bf16x8*)((kb_) + 32 * KP + (2 * (pr) + 1) * 32); } while (0)
#define KMM(src, pr) do { p0 = MFMA32(src[0], q[2 * (pr)], p0); p1 = MFMA32(src[1], q[2 * (pr)], p1); p0 = MFMA32(src[2], q[2 * (pr) + 1], p0); p1 = MFMA32(src[3], q[2 * (pr) + 1], p1); } while (0)
#define SB0() __builtin_amdgcn_sched_barrier(0)
#define QKT(buf) do { const LAS unsigned char* kb_ = lds + L_K + (buf) * KBUF + r32 * KP + h * 16; bf16x8 ka[4], kb2[4]; \
        KRD(ka, kb_, 0); SB0(); \
        KRD(kb2, kb_, 1); p0 = MFMA32(ka[0], q[0], cin); p1 = MFMA32(ka[1], q[0], cin); p0 = MFMA32(ka[2], q[1], p0); p1 = MFMA32(ka[3], q[1], p1); SB0(); \
        KRD(ka, kb_, 2); KMM(kb2, 1); SB0(); \
        KRD(kb2, kb_, 3); KMM(ka, 2); SB0(); \
        KMM(kb2, 3); SB0(); } while (0)
    const int vlane = (4 * h + ((lane & 15) >> 2)) * VP + ((lane >> 4) & 1) * 32 + (lane & 3) * 8;
    f32x16 p0, p1, cin; bf16x8 pk0, pk1, pk2_, pk3;
    float mref, l;
    const bool lagw = __builtin_amdgcn_readfirstlane(tid) >= 256;
    if (lagw) __builtin_amdgcn_s_setprio(1);
    r0 = fk0; r1 = fk1; LSTOREK(0); r2 = fv0; r3 = fv1; LSTOREV(0);
#pragma unroll
    for (int d = 0; d < 4; ++d)
#pragma unroll
        for (int i = 0; i < 16; ++i) o[d][i] = 0.f;
    __syncthreads();
    { const bool more = ntiles > 1;
      if (more) GLOADX(Kg, c - 1);
#pragma unroll
      for (int i = 0; i < 16; ++i) cin[i] = 0.f;
      QKT(0);
      float rm = NEG;
#pragma unroll
      for (int i = 0; i < 16; ++i) { const int k0 = crow(i, h), k1 = k0 + 32;
          p0[i] = (k0 <= tokoff) ? p0[i] : NEG; p1[i] = (k1 <= tokoff) ? p1[i] : NEG; rm = fmaxf(fmaxf(rm, p0[i]), p1[i]); }
      rm = fmaxf(rm, xhalf(rm));
      mref = rm; float rs = 0.f;
#pragma unroll
      for (int i = 0; i < 16; ++i) { p0[i] = ex2(p0[i] - rm); p1[i] = ex2(p1[i] - rm); rs += p0[i] + p1[i]; }
      l = rs;
      pk0 = pack8(p0, 0); pk1 = pack8(p0, 8); pk2_ = pack8(p1, 0); pk3 = pack8(p1, 8);
      if (BR == 2) {
#pragma unroll
          for (int i = 0; i < 16; ++i) cin[i] = -mref; }
      if (more) LSTOREK(1);
      __syncthreads(); }
#pragma clang loop unroll(disable)
    for (int t = 1; t < ntiles; ++t) {
        const int j = c - t, kbuf = t & 1;
        const bool more = (t + 1 < ntiles);
        if (more) GLOADX(Kg, j - 1);
        GLOADV(Vg, j);
        if (BR == 1) { const float ci = ((selmask >> j) & 1u) ? -mref : NEG;
#pragma unroll
            for (int i = 0; i < 16; ++i) cin[i] = ci; }
        QKT(kbuf);
        if (BR == 2 && j == c - 8) {
#pragma unroll
            for (int i = 0; i < 16; ++i) { const int k0 = crow(i, h), k1 = k0 + 32; p0[i] = (k0 > tokoff) ? p0[i] : NEG; p1[i] = (k1 > tokoff) ? p1[i] : NEG; }
        }
        SB0();
        float rs0 = 0.f, rs1 = 0.f;
        const LAS unsigned char* vb = lds + L_V + (kbuf ^ 1) * VBUF + vlane;
#define SMQ(k) do { _Pragma("unroll") for (int i = 4 * (k); i < 4 * (k) + 4; ++i) { p0[i] = ex2(p0[i]); p1[i] = ex2(p1[i]); rs0 = fadd_s(rs0, p0[i]); rs1 = fadd_s(rs1, p1[i]); } } while (0)
#define VRD(lo_, hi_, s_) do { _Pragma("unroll") for (int d = 0; d < 4; ++d) { lo_[d] = vtr(vb + (16 * (s_)) * VP + d * 64); hi_[d] = vtr(vb + (16 * (s_) + 8) * VP + d * 64); } } while (0)
#define VMM(lo_, hi_, pk_) do { _Pragma("unroll") for (int d = 0; d < 4; ++d) o[d] = MFMA32(__builtin_shufflevector(lo_[d], hi_[d], 0, 1, 2, 3, 4, 5, 6, 7), pk_, o[d]); } while (0)
        { s16x4 la[4], ha[4];
          VRD(la, ha, 0); SMQ(0); VMM(la, ha, pk0); SB0();
          VRD(la, ha, 1); SMQ(1); VMM(la, ha, pk1); SB0();
          VRD(la, ha, 2); SMQ(2); VMM(la, ha, pk2_); SB0();
          VRD(la, ha, 3); SMQ(3); VMM(la, ha, pk3); SB0(); }
#undef SMQ
        float rs = rs0 + rs1;
        if (__any(rs > 512.0f)) {
            float me = fmaxf(p0[0], p1[0]);
#pragma unroll
            for (int i = 1; i < 16; ++i) me = fmaxf(fmaxf(me, p0[i]), p1[i]);
            me = fmaxf(me, xhalf(me));
            const bool grow = me > 256.0f; const float delta = grow ? __builtin_amdgcn_logf(me) : 0.f, alpha = grow ? __builtin_amdgcn_rcpf(me) : 1.f; mref += delta; l *= alpha; rs *= alpha;
#pragma unroll
            for (int i = 0; i < 16; ++i) { p0[i] *= alpha; p1[i] *= alpha; }
#pragma unroll
            for (int d = 0; d < 4; ++d)
#pragma unroll
                for (int i = 0; i < 16; ++i) o[d][i] *= alpha;
            if (BR == 2) {
#pragma unroll
                for (int i = 0; i < 16; ++i) cin[i] = -mref; }
        }
        l += rs;
        pk0 = pack8(p0, 0); pk1 = pack8(p0, 8); pk2_ = pack8(p1, 0); pk3 = pack8(p1, 8);
        if (more) LSTOREK(kbuf ^ 1);
        LSTOREV(kbuf);
        __syncthreads();
    }
    if (Kn) { const char* p_ = (const char*)Kn + (size_t)c * 16384; fk0 = *(const u32x4*)(p_ + goff); fk1 = *(const u32x4*)(p_ + 8192 + goff); p_ = (const char*)Vn + (size_t)c * 16384; fv0 = *(const u32x4*)(p_ + goff); fv1 = *(const u32x4*)(p_ + 8192 + goff); }
    { const LAS unsigned char* vb = lds + L_V + ((ntiles - 1) & 1) * VBUF + vlane;
      pv_step(o, vb, pk0); pv_step(o, vb + 16 * VP, pk1); pv_step(o, vb + 32 * VP, pk2_); pv_step(o, vb + 48 * VP, pk3); }
    __syncthreads();
#undef GLOADX
#undef LSTOREK
#undef LSTOREV
#undef GLOADV
#undef QKT
#undef KRD
#undef KMM
#undef VRD
#undef VMM
#undef SB0
    if (lagw) __builtin_amdgcn_s_setprio(0);
    lsum = l + xhalf(l);
}

DI void attn_unit(LAS unsigned char* lds, unsigned char* ws, int bg, int c, int tid_in, int wave) {
    int tid = tid_in; asm volatile("" : "+v"(tid));
    const int lane = tid & 63;
    const int b = bg >> 2, g = bg & 3, h = lane >> 5, r32 = lane & 31, hh = wave >> 1, th = wave & 1, head = 4 * g + hh;
    const int tokoff = 32 * th + r32; const size_t trow = (size_t)b * 2048 + 64 * c + tokoff;
    bf16x8 q[8];
    { const bf16_t* qp = (const bf16_t*)(ws + pg8::WS_Q) + trow * 2048 + head * 128 + 8 * h;
#pragma unroll
      for (int ks = 0; ks < 8; ++ks) q[ks] = *(const bf16x8*)(qp + 16 * ks); }
    const bf16_t* gn = (const bf16_t*)(ws + pg8::WS_GN) + trow * 256 + head;
    const float g0 = bf2f(gn[0]), g1 = bf2f(gn[16]), g2 = bf2f(gn[32]);
#define PARKP(d, u) ((LAS u32x2*)(lds + L_PARK + wave * 8192 + ((d) * 4 + (u)) * 512 + lane * 8))
    const bf16_t* const KSg = (const bf16_t*)(ws + pg8::WS_KC + 2 * pg8::SZ_KV) + (size_t)bg * 2048 * 128; const bf16_t* const VSg = (const bf16_t*)(ws + pg8::WS_KC + 3 * pg8::SZ_KV) + (size_t)bg * 2048 * 128;
    const bf16_t* const KWg = (const bf16_t*)(ws + pg8::WS_KC + 4 * pg8::SZ_KV) + (size_t)bg * 2048 * 128; const bf16_t* const VWg = (const bf16_t*)(ws + pg8::WS_KC + 5 * pg8::SZ_KV) + (size_t)bg * 2048 * 128;
    u32x4 fk0, fk1, fv0, fv1;
    f32x16 o[4]; float g0s = 0.f;
#ifndef ATT_SKIP_CMP
    {
        const bf16_t* kc = (const bf16_t*)(ws + pg8::WS_KCB) + (size_t)bg * 128 * 128; const bf16_t* vc = (const bf16_t*)(ws + pg8::WS_VCB) + (size_t)bg * 128 * 128;
#pragma unroll
        for (int x = 0; x < 4; ++x) { const int ch = tid + 512 * x, key = ch >> 4, part = ch & 15;
            *(LAS u32x4*)(lds + L_K + key * KP + part * 16) = *(const u32x4*)(kc + key * 128 + part * 8);
            *(LAS u32x4*)(lds + L_V + key * VP + part * 16) = *(const u32x4*)(vc + key * 128 + part * 8); }
        __syncthreads();
        f32x16 s[4];
        const int ntc = (4 * c + 3 + 31) >> 5;
        const int tok = 64 * c + tokoff; const int nvis = (tok >= 31) ? ((tok - 31) >> 4) + 1 : 0;
#pragma unroll
        for (int t = 0; t < 4; ++t)
#pragma unroll
            for (int i = 0; i < 16; ++i) s[t][i] = NEG;
#pragma unroll
        for (int tp = 0; tp < 2; ++tp) if (2 * tp < ntc) {
            f32x16 a0, a1;
#pragma unroll
            for (int i = 0; i < 16; ++i) { a0[i] = 0.f; a1[i] = 0.f; }
            const LAS unsigned char* kb = lds + L_K + (64 * tp + r32) * KP + h * 16;
#pragma unroll
            for (int ks = 0; ks < 8; ++ks) { a0 = MFMA32(*(const LAS bf16x8*)(kb + ks * 32), q[ks], a0); a1 = MFMA32(*(const LAS bf16x8*)(kb + 32 * KP + ks * 32), q[ks], a1); if (ks & 1) __builtin_amdgcn_sched_barrier(0); }
            if (64 * tp + 64 > 4 * c - 1) {
#pragma unroll
                for (int i = 0; i < 16; ++i) { const int n = 64 * tp + crow(i, h); a0[i] = (n < nvis) ? a0[i] : NEG; a1[i] = (n + 32 < nvis) ? a1[i] : NEG; }
            }
            s[2 * tp] = a0; s[2 * tp + 1] = a1;
        }
        float m = NEG;
#pragma unroll
        for (int t = 0; t < 4; ++t)
#pragma unroll
            for (int i = 0; i < 16; ++i) m = fmaxf(m, s[t][i]);
        m = fmaxf(m, xhalf(m));
        float l = 0.f;
#pragma unroll
        for (int t = 0; t < 4; ++t)
#pragma unroll
            for (int i = 0; i < 16; ++i) { s[t][i] = ex2(s[t][i] - m); l += s[t][i]; }
        l += xhalf(l);
        const float inv = (nvis > 0) ? 1.0f / l : 0.f;
        LAS float* impH = (LAS float*)(lds + L_IMPH) + (hh * 64 + tokoff) * 33;
#pragma unroll
        for (int t = 0; t < 4; ++t)
#pragma unroll
            for (int u = 0; u < 4; ++u) {
                const float bown = 0.5f * s[t][4 * u + 3];
                float bprev = 0.f; if (u > 0) bprev = 0.5f * s[t][4 * u - 1]; else if (t > 0) bprev = 0.5f * s[t - 1][15];
                const float send = h ? bprev : bown;
                const float recv = xhalf(send);
                const float a = s[t][4 * u] + s[t][4 * u + 1] + s[t][4 * u + 2] + bown;
                impH[8 * t + 2 * u + h] = (a + recv) * inv;
            }
#pragma unroll
        for (int d = 0; d < 4; ++d)
#pragma unroll
            for (int i = 0; i < 16; ++i) o[d][i] = 0.f;
        const LAS unsigned char* vb = lds + L_V + (4 * h + ((lane & 15) >> 2)) * VP + ((lane >> 4) & 1) * 32 + (lane & 3) * 8;
#pragma unroll
        for (int t = 0; t < 4; ++t) if (t < ntc) { pv_step(o, vb + (32 * t) * VP, pack8(s[t], 0)); pv_step(o, vb + (32 * t + 16) * VP, pack8(s[t], 8)); }
        g0s = g0 * inv;
        { const char* p_ = (const char*)KSg + (size_t)c * 16384 + (unsigned)tid * 16u; fk0 = *(const u32x4*)p_; fk1 = *(const u32x4*)(p_ + 8192);
          p_ = (const char*)VSg + (size_t)c * 16384 + (unsigned)tid * 16u; fv0 = *(const u32x4*)p_; fv1 = *(const u32x4*)(p_ + 8192); }
        __syncthreads();
        { LAS float* IH = (LAS float*)(lds + L_IMPH); LAS unsigned* IM = (LAS unsigned*)(lds + L_IMP);
#pragma unroll
          for (int x = 0; x < 4; ++x) { const int e = tid + 512 * x, j = e & 31;
              const int ei = (e >> 5) * 33 + j;
              float v = ((IH[ei] + IH[64 * 33 + ei]) + IH[2 * 64 * 33 + ei]) + IH[3 * 64 * 33 + ei];
              const bool causal = j <= c, forced = (j == 0 || j == c || j == c - 1);
              v = forced ? 1e4f : v;
              IM[e] = causal ? ((__float_as_uint(v) & ~31u) | (unsigned)(31 - j)) : 0u; }
          __syncthreads();
          LAS unsigned* MK = (LAS unsigned*)(lds + L_MASK);
#pragma unroll
          for (int x = 0; x < 4; ++x) { const int e = tid + 512 * x, tk = e >> 5, j = e & 31; const unsigned v = IM[e]; int cnt = 0;
#pragma unroll
              for (int i4 = 0; i4 < 8; ++i4) { const u32x4 w = *(const LAS u32x4*)(IM + tk * 32 + 4 * i4);
                  cnt += (w.x > v) + (w.y > v) + (w.z > v) + (w.w > v); }
              const unsigned long long bal = __ballot(cnt < 8 && j <= c);
              if ((lane & 31) == 0) MK[tk] = (unsigned)(bal >> (lane & 32)); }
          __syncthreads(); }
    }
#endif
    const unsigned selmask = ((const LAS unsigned*)(lds + L_MASK))[tokoff];
#pragma unroll
    for (int d = 0; d < 4; ++d)
#pragma unroll
        for (int u = 0; u < 4; ++u) { u32x2 w; w.x = pk2(o[d][4 * u] * g0s, o[d][4 * u + 1] * g0s); w.y = pk2(o[d][4 * u + 2] * g0s, o[d][4 * u + 3] * g0s); *PARKP(d, u) = w; }
    float lsum = 1.f;
#ifndef ATT_SKIP_SEL
    flash<1>(lds, KSg, VSg, c, q, o, lsum, selmask, tokoff, lane, tid, fk0, fk1, fv0, fv1, KWg, VWg);
#endif
    { const float sc = g1 / lsum;
#pragma unroll
      for (int d = 0; d < 4; ++d)
#pragma unroll
          for (int u = 0; u < 4; ++u) { const u32x2 pw = *PARKP(d, u); u32x2 w;
              w.x = pk2(bflo(pw.x) + o[d][4 * u] * sc, bfhi(pw.x) + o[d][4 * u + 1] * sc); w.y = pk2(bflo(pw.y) + o[d][4 * u + 2] * sc, bfhi(pw.y) + o[d][4 * u + 3] * sc); *PARKP(d, u) = w; } }
#ifndef ATT_SKIP_WIN
    flash<2>(lds, KWg, VWg, c, q, o, lsum, 0u, tokoff, lane, tid, fk0, fk1, fv0, fv1, (const bf16_t*)nullptr, (const bf16_t*)nullptr);
#endif
    { const float sc = g2 / lsum; LAS unsigned char* stg = lds + wave * (32 * 272);
      const size_t ub = (((size_t)b * 2048 + 64 * c + 32 * th) * 2048 + head * 128) * 2;
      const char* ZA = (const char*)(ws + pg8::WS_ZA) + ub; char* A1 = (char*)(ws + pg8::WS_A1) + ub;
      const unsigned lo_ = (unsigned)((lane >> 4) * 2048 + (lane & 15) * 8) * 2u;
      u32x4 z[8];
#pragma unroll
      for (int x = 0; x < 8; ++x) z[x] = __builtin_nontemporal_load((const u32x4*)(ZA + (size_t)x * (4 * 2048 * 2) + lo_));
#pragma unroll
      for (int d = 0; d < 4; ++d)
#pragma unroll
          for (int u = 0; u < 4; ++u) { const u32x2 pw = *PARKP(d, u); u32x2 w;
              w.x = pk2(bflo(pw.x) + o[d][4 * u] * sc, bfhi(pw.x) + o[d][4 * u + 1] * sc); w.y = pk2(bflo(pw.y) + o[d][4 * u + 2] * sc, bfhi(pw.y) + o[d][4 * u + 3] * sc);
              *(LAS u32x2*)(stg + r32 * 272 + (32 * d + 8 * u + 4 * h) * 2) = w; }
      LDS_WAIT();
#pragma unroll
      for (int x = 0; x < 8; ++x) { const int idx = x * 64 + lane, row = idx >> 4, pt = idx & 15; const u32x4 v = *(const LAS u32x4*)(stg + row * 272 + pt * 16);
          const size_t go = (size_t)x * (4 * 2048 * 2) + lo_;
          u32x4 w; w.x = pk2(bflo(v.x) * bflo(z[x].x), bfhi(v.x) * bfhi(z[x].x)); w.y = pk2(bflo(v.y) * bflo(z[x].y), bfhi(v.y) * bfhi(z[x].y));
          w.z = pk2(bflo(v.z) * bflo(z[x].z), bfhi(v.z) * bfhi(z[x].z)); w.w = pk2(bflo(v.w) * bflo(z[x].w), bfhi(v.w) * bfhi(z[x].w));
          *(u32x4*)(A1 + go) = w; }
    }
#undef PARKP
    __syncthreads();
}
}
#define XB_TMO      128
#define XB_XCNT(j)  (256  + 64 * (j))
#define XB_XSUB(j)  (1280 + 64 * (j))
#define XB_XGEN(j)  (2304 + 64 * (j))
#define XB_TOP      3328
#define XB_TOPGEN   3392
#define XCD_BAR_WORDS 3456
#define XB_SPIN_CAP (1u << 18)

__device__ __forceinline__ unsigned xb_ld(unsigned* p)              { return __hip_atomic_load(p, __ATOMIC_RELAXED, __HIP_MEMORY_SCOPE_AGENT); }
__device__ __forceinline__ unsigned xb_add(unsigned* p, unsigned v) { return __hip_atomic_fetch_add(p, v, __ATOMIC_RELAXED, __HIP_MEMORY_SCOPE_AGENT); }
__device__ __forceinline__ unsigned xb_xcc_id() { return (unsigned)__builtin_amdgcn_s_getreg((3 << 11) | 20) & 0xFu; }
#define XB_SPIN(cond, bar) do { unsigned _sp = 0; while (cond) { __builtin_amdgcn_s_sleep(1); \
    if ((++_sp & 255u) == 0u) { if (xb_ld(&(bar)[XB_TMO])) break; if (_sp > XB_SPIN_CAP) { atomicAdd(&(bar)[XB_TMO], 1u); break; } } } } while (0)

struct XcdBarrier {
    unsigned* bar; unsigned x;
    volatile LAS unsigned* st;
};

__device__ __forceinline__ XcdBarrier xcd_barrier_post(unsigned* bar, volatile LAS unsigned* st) {
    XcdBarrier b; b.bar = bar; b.x = xb_xcc_id(); b.st = st;
    if (threadIdx.x == 0) (void)xb_add(&bar[XB_XCNT(b.x)], 1u);
    return b;
}
__device__ __forceinline__ void xcd_barrier_complete(unsigned* bar, unsigned x, unsigned& nloc, unsigned& nx) {
    const unsigned G = gridDim.x * gridDim.y * gridDim.z;
    unsigned sum, cnt, mine, sp = 0u;
    for (;;) {
        sum = 0u; cnt = 0u; mine = 0u;
#pragma unroll
        for (unsigned j = 0; j < 16; ++j) { const unsigned c = xb_ld(&bar[XB_XCNT(j)]); sum += c; cnt += (c > 0u) ? 1u : 0u; mine = (j == x) ? c : mine; }
        if (sum == G) break;
        __builtin_amdgcn_s_sleep(1);
        if ((++sp & 255u) == 0u) { if (xb_ld(&bar[XB_TMO])) break; if (sp > XB_SPIN_CAP) { atomicAdd(&bar[XB_TMO], 1u); break; } }
    }
    nloc = mine > 0u ? mine : 1u; nx = cnt > 0u ? cnt : 1u;
}

__device__ __forceinline__ void xcd_barrier_protocol(const XcdBarrier& b) {
        unsigned* bar = b.bar;
        __builtin_amdgcn_s_waitcnt(0);
        unsigned nloc = b.st[0], nx = b.st[1];
        if (nloc == 0u) { xcd_barrier_complete(bar, b.x, nloc, nx); b.st[0] = nloc; b.st[1] = nx; }
        const unsigned old = xb_add(&bar[XB_XSUB(b.x)], 1u);
        const unsigned gen = old / nloc;
        if (old + 1u == (gen + 1u) * nloc) {
            __builtin_amdgcn_fence(__ATOMIC_RELEASE, "agent");
            asm volatile("s_waitcnt vmcnt(0)" ::: "memory");
            const unsigned og = xb_add(&bar[XB_TOP], 1u);
            const unsigned tg = og / nx;
            if (og + 1u == (tg + 1u) * nx) xb_add(&bar[XB_TOPGEN], 1u);
            else XB_SPIN(xb_ld(&bar[XB_TOPGEN]) == tg, bar);
            __builtin_amdgcn_fence(__ATOMIC_ACQUIRE, "agent");
            xb_add(&bar[XB_XGEN(b.x)], 1u);
            asm volatile("s_waitcnt vmcnt(0)" ::: "memory");
        } else {
            XB_SPIN(xb_ld(&bar[XB_XGEN(b.x)]) == gen, bar);
            __builtin_amdgcn_fence(__ATOMIC_ACQUIRE, "agent");
            asm volatile("s_waitcnt vmcnt(0)" ::: "memory");
        }
}
__device__ __forceinline__ void xcd_barrier(const XcdBarrier& b) {
    asm volatile("s_waitcnt vmcnt(0)" ::: "memory");
    __syncthreads();
    if (threadIdx.x == 0) xcd_barrier_protocol(b);
    __syncthreads();
}

#ifndef MK_N_LAUNCHES
#define MK_N_LAUNCHES 1
#endif
constexpr int N_PHASES = 8;
#ifndef GEMM_REP_MASK
#define GEMM_REP_MASK 0
#endif
template <int SHIFT> struct RepOrder : pg8::StaticOrder {
    __device__ bool next(int i, pg8::Unit& u) const { return pg8::StaticOrder::next(i >> SHIFT, u); }
};
struct RevOrder : pg8::StaticOrder {
    __device__ bool next(int i, pg8::Unit& u) const { if (!pg8::StaticOrder::next(i, u)) return false; u.pn = nN - 1 - u.pn; return true; }
};
#define GREP(k) (((GEMM_REP_MASK) >> (k)) & 1)
struct ChainOrder : pg8::StaticOrder {
    __device__ bool next(int i, pg8::Unit& u) const { if (!pg8::StaticOrder::next(i >> 1, u)) return false; if (i & 1) { u.pm += 32; u.pn += 8; } return true; }
};
struct TwiceOrder : pg8::StaticOrder {
    __device__ bool next(int i, pg8::Unit& u) const { const int cnt = (nwg - c + G - 1) / G; return i < cnt ? pg8::StaticOrder::next(i, u) : (i < 2 * cnt ? pg8::StaticOrder::next(i - cnt, u) : false); }
};
constexpr int LDS_BYTES = 147456;
static_assert(att::L_END <= 146944 && pg8::STAGE_BYTES <= 131072, "LDS map");

__global__ void __launch_bounds__(512, 2) nsa_hybrid_fwd(Args a) {
    extern __shared__ __attribute__((aligned(16))) unsigned char lds_raw[];
    LAS unsigned char* lds = (LAS unsigned char*)lds_raw;
    for (int u = threadIdx.x; u < 128; u += 512) ((LAS unsigned*)(lds + 146944))[u] = 0u;
    __syncthreads();
    XcdBarrier bar = xcd_barrier_post((unsigned*)(a.ws + pg8::WS_CTL), (volatile LAS unsigned*)(lds + 146944 + 32));
    const int tid = threadIdx.x, lane = tid & 63, wave = __builtin_amdgcn_readfirstlane(tid >> 6);
    const int G = gridDim.x, bx = blockIdx.x;
    const int vcu = (G % 8 == 0) ? (bx % 8) * (G / 8) + bx / 8 : bx;
    unsigned char* ws = a.ws;
    const int lo = a.ph_lo, hi = a.ph_hi;
#ifndef PHASE_MASK
#define PHASE_MASK 0x1ff
#endif
#define IN(k) (((PHASE_MASK >> (k)) & 1) && lo <= (k) && (k) < hi)
#ifndef REPEAT_MASK
#define REPEAT_MASK 0
#endif
#define REPS(k) _Pragma("clang loop unroll(disable)") for (int rep_ = 0; rep_ < ((((REPEAT_MASK) >> (k)) & 1) ? a.ph_rep : 1); ++rep_)
#define SEAM(k) do { if (IN(k) && IN((k) + 1)) xcd_barrier(bar); } while (0)

    if (IN(0)) REPS(0) p0_phase<0>(lds, a, vcu, G, tid, lane, wave);
    SEAM(0);
    if (IN(1)) REPS(1) {
        pg8::Gemm g{(const bf16_t*)(ws + pg8::WS_HN), (const bf16_t*)(ws + pg8::WS_WIN), TOK, NPAD, DM}; RevOrder S; S.init(TOK, NPAD, G, bx);
        pg8::EpiIn E{ws, (const float*)(ws + pg8::WS_BIAS)};
        pg8::gemm_phase<pg8::EpiIn, RevOrder, true, true>(lds, g, S, E);
        { const int nfull = (77 * 32) % G; if (nfull != 0 && bx >= nfull) p0_phase<1>(lds, a, bx - nfull, G - nfull, tid, lane, wave); else if (nfull == 0) p0_phase<1>(lds, a, bx, G, tid, lane, wave); }
    }
    SEAM(1);
    if (IN(2)) REPS(2) {
        const int jb = bx >> 4, which = (jb >> 2) & 1, sp = jb & 3; const bool gj = bx < 128;
        { pg8::Gemm g{(const bf16_t*)(ws + pg8::WS_KC + (size_t)which * pg8::SZ_KV) + sp * 512, (const bf16_t*)(ws + (which ? pg8::WS_W1V : pg8::WS_W1K)) + sp * 512, 2048, 512, 512, 2048, 2048};
          RepOrder<GREP(2)> S; S.init(2048, 512, G, gj ? (bx & 15) : 16);
          pg8::EpiPlain E{(bf16_t*)(ws + (which ? pg8::WS_PQV : pg8::WS_PQK)) + (size_t)sp * 2048 * 512, 512}; pg8::gemm_phase<pg8::EpiPlain, RepOrder<GREP(2)>, true, true>(lds, g, S, E); }
        { const int hb = tid >> 8;
          if (gj) conv_run(ws, a.in[10], a.in[11], 768 + 2 * bx + hb, tid);
          else {
#pragma unroll 1
              for (int r = 0; r < 3; ++r) conv_run(ws, a.in[10], a.in[11], 6 * (bx - 128) + 2 * r + hb, tid); } }
    }
    SEAM(2);
    if (IN(3)) REPS(3) p3_phase(lds, ws, a.in[6], a.in[9], bx, G, tid);
    SEAM(3);
    if (IN(4)) REPS(4) {
        for (int pidx = vcu; pidx < 256; pidx += G) { const int bg = pidx >> 4, s = pidx & 15;
#pragma unroll 1
            for (int u2 = 0; u2 < 2; ++u2) att::attn_unit(lds, ws, bg, u2 ? s : 31 - s, tid, wave); }
    }
    SEAM(4);
    if (IN(5)) {
        pg8::Gemm g{(const bf16_t*)(ws + pg8::WS_A1), (const bf16_t*)(ws + pg8::WS_PAT), TOK, DM, DM}; ChainOrder S; S.init(TOK, DM, G, bx);
        pg8::EpiYChain E{(bf16_t*)(ws + pg8::WS_Y), (const bf16_t*)(ws + pg8::WS_GM)};
        pg8::gemm_phase<pg8::EpiYChain, ChainOrder, true, true>(lds, g, S, E);
    }
    f32x4 xacc[2][2][4][2];
    { pg8::StaticOrder S7; S7.init(TOK, DM, G, bx); pg8::Unit u7; u7.pm = 0; u7.pn = 0; (void)S7.next(0, u7);
      const float* xl = a.in[0] + (size_t)(u7.pm * 256 + (wave >> 2) * 64 + (lane & 15)) * 2048 + u7.pn * 256 + (wave & 3) * 32 + 8 * (lane >> 4);
#define LDX() do { _Pragma("unroll") for (int ai = 0; ai < 2; ++ai) _Pragma("unroll") for (int bj = 0; bj < 2; ++bj) _Pragma("unroll") for (int m = 0; m < 4; ++m) _Pragma("unroll") for (int n = 0; n < 2; ++n) \
          xacc[ai][bj][m][n] = __builtin_nontemporal_load((const f32x4*)(xl + (size_t)(ai * 128 + m * 16) * 2048 + bj * 128 + 4 * n)); } while (0)
      if (IN(6) && IN(7)) {
          asm volatile("s_waitcnt vmcnt(0)" ::: "memory"); __syncthreads();
          if (threadIdx.x != 0) LDX();
          if (threadIdx.x == 0) { xcd_barrier_protocol(bar); LDX(); }
          __syncthreads(); }
      else if (IN(7)) LDX();
#undef LDX
    }
    if (IN(7)) {
        pg8::Gemm g{(const bf16_t*)(ws + pg8::WS_Y), (const bf16_t*)(ws + pg8::WS_WOT), TOK, DM, DM}; pg8::StaticOrder S; S.init(TOK, DM, G, bx);
        pg8::EpiOutNorm E{a.in[0], a.out, a.in[15], (float*)(ws + pg8::WS_SLOTS), (unsigned*)(ws + pg8::WS_CTL) + pg8::CW_PANEL};
        pg8::gemm_phase<pg8::EpiOutNorm, pg8::StaticOrder, false, true>(lds, g, S, E, xacc);
    }
#undef IN
#undef SEAM
}

extern "C" void kernel_launch(void* const* d_in, const int* in_sizes, int n_in, void* d_out, int out_size, void* d_ws, size_t ws_size, hipStream_t stream) {
    static int grid = 0;
    if (grid == 0) {
        if (n_in != 16 || out_size != TOK * DM || ws_size < pg8::WS_END) { fprintf(stderr, "kernel_launch: unexpected shapes (n_in %d, out %d, ws %zu < %zu)\n", n_in, out_size, ws_size, (size_t)pg8::WS_END); grid = -1; return; }
        int dev = 0, cus = 0, per_cu = 0;
        (void)hipGetDevice(&dev); (void)hipDeviceGetAttribute(&cus, hipDeviceAttributeMultiprocessorCount, dev);
        (void)hipFuncSetAttribute((const void*)nsa_hybrid_fwd, hipFuncAttributeMaxDynamicSharedMemorySize, LDS_BYTES);
        (void)hipOccupancyMaxActiveBlocksPerMultiprocessor(&per_cu, (const void*)nsa_hybrid_fwd, 512, LDS_BYTES);
        if (per_cu < 1) { fprintf(stderr, "kernel_launch: occupancy query says %d blocks/CU\n", per_cu); per_cu = 1; }
        grid = cus * per_cu; if (grid > 256) grid = 256;
        if (grid != 256) { fprintf(stderr, "kernel_launch: this kernel needs 256 resident workgroups (got %d)\n", grid); grid = -1; return; }
    }
    if (grid < 0) return;
    (void)hipMemsetAsync((char*)d_ws + pg8::WS_CTL, 0, 65536, stream);
    Args a{};
    for (int i = 0; i < 16; ++i) a.in[i] = (const float*)d_in[i];
    a.out = (float*)d_out; a.ws = (unsigned char*)d_ws; a.ph_rep = 2;
#if MK_N_LAUNCHES == 1
    a.ph_lo = 0; a.ph_hi = N_PHASES;
    { void* args[] = {&a}; hipError_t e = hipLaunchCooperativeKernel((const void*)nsa_hybrid_fwd, dim3(grid), dim3(512), args, LDS_BYTES, stream);
      if (e != hipSuccess) fprintf(stderr, "cooperative launch failed: %s (grid %d)\n", hipGetErrorString(e), grid); }
#else
    for (int p = 0; p < N_PHASES; ++p) { a.ph_lo = p; a.ph_hi = p + 1;
        hipLaunchKernelGGL(nsa_hybrid_fwd, dim3(grid), dim3(512), LDS_BYTES, stream, a); }
#endif
}
```

```cpp
#include <hip/hip_runtime.h>
#include <hip/hip_cooperative_groups.h>
#include <cstdio>
#include <cstdint>
namespace cg = cooperative_groups;
namespace pg8 {
#define PG8_LAS __attribute__((address_space(3)))
typedef unsigned short bf16_t;
typedef short bf16x8 __attribute__((ext_vector_type(8)));
typedef float f32x4 __attribute__((ext_vector_type(4)));
typedef unsigned u32x4 __attribute__((ext_vector_type(4)));
constexpr int BM = 256, BK = 64, HALF = 128, HTB = HALF * BK * 2  , STAGE_BYTES = 8 * HTB, NXCD = 8, WGM = 8;

__host__ __device__ __forceinline__ int lds_byte(int r, int c) { const int st = (r >> 4) * 2 + (c >> 5), rr = r & 15, cc = c & 31, ob = rr * 64 + cc * 2; return st * 1024 + (ob ^ (((ob >> 9) & 1) << 5)); }
__host__ __device__ __forceinline__ void stage_rc(int b, int& R, int& C) { const int st = b / 1024, sb = b % 1024, swz = sb ^ (((sb >> 9) & 1) << 5); R = (st >> 1) * 16 + swz / 64; C = (st & 1) * 32 + (swz % 64) / 2; }
__host__ __device__ __forceinline__ int perm32(int rho) { const int n = rho >> 4, i = rho & 15; return 8 * (i >> 2) + 4 * n + (i & 3); }

struct Unit { int pm, pn; };
struct Gemm { const bf16_t* A; const bf16_t* Bt; int M, N, K; int lda = 0, ldb = 0; };

struct StaticOrder {
    int nM, nN, nwg, G, c;
    __host__ __device__ void init(int M, int N, int G_, int c_) { nM = M / BM; nN = N / BM; nwg = nM * nN; G = G_; c = c_; }
    __host__ __device__ bool next(int i, Unit& u) const {
        const long L = (long)i * G + c; if (L >= nwg) return false;
        int wgid = (int)L; { const int q = nwg / NXCD, r = nwg % NXCD, xcd = wgid % NXCD, off = wgid / NXCD; wgid = (xcd < r ? xcd * (q + 1) : r * (q + 1) + (xcd - r) * q) + off; }
        const int nig = WGM * nN, gid = wgid / nig, fm = gid * WGM, gsz = (nM - fm) < WGM ? (nM - fm) : WGM;
        u.pm = fm + ((wgid % nig) % gsz); u.pn = (wgid % nig) / gsz; return true;
    }
    __device__ __forceinline__ void a_ready(const Unit&) const {}
    __device__ __forceinline__ void done(const Unit&) const {}
};

__device__ __forceinline__ unsigned cvt_pk_bf16(float lo, float hi) { unsigned r; asm volatile("v_cvt_pk_bf16_f32 %0, %1, %2" : "=v"(r) : "v"(lo), "v"(hi)); return r; }
typedef float f32x2 __attribute__((ext_vector_type(2)));
typedef float f32x2_t __attribute__((ext_vector_type(2))); typedef __bf16 bf16x2_t __attribute__((ext_vector_type(2)));
__device__ __forceinline__ unsigned pk2(float lo, float hi) { f32x2_t v = {lo, hi}; bf16x2_t b = __builtin_convertvector(v, bf16x2_t); return __builtin_bit_cast(unsigned, b); }
__device__ __forceinline__ float bflo(unsigned w) { return __uint_as_float(w << 16); }
__device__ __forceinline__ float bfhi(unsigned w) { return __uint_as_float(w & 0xffff0000u); }
__device__ __forceinline__ float sigm_f(float v) { return __builtin_amdgcn_rcpf(1.f + __builtin_amdgcn_exp2f(-1.4426950408889634f * v)); }
__device__ __forceinline__ float silu_f(float v) { return v * sigm_f(v); }
constexpr int TOK = 8192, DM = 2048, NPAD = 19712;
constexpr float QSCALE = 0.08838834764831845f * 1.4426950408889634f;
constexpr size_t al256(size_t x) { return (x + 255) & ~(size_t)255; }
constexpr size_t SZ_TD = (size_t)TOK * DM * 2, SZ_KV = (size_t)TOK * 512 * 2, SZ_W = (size_t)DM * DM * 2;
constexpr size_t WS_CTL = 0;
constexpr size_t WS_WIN = 65536;
constexpr size_t WS_A1 = WS_WIN, WS_A2 = WS_WIN + SZ_TD;
constexpr size_t WS_HN = al256(WS_WIN + (size_t)NPAD * DM * 2);
constexpr size_t WS_Y = WS_HN;
constexpr size_t WS_PAT = WS_HN + SZ_TD, WS_PCT = WS_PAT + SZ_W, WS_WOT = WS_PCT + SZ_W;
constexpr size_t WS_W1K = WS_WOT + SZ_W, WS_W1V = WS_W1K + (size_t)512 * DM * 2;
constexpr size_t WS_BIAS = WS_W1V + (size_t)512 * DM * 2;
constexpr size_t WS_CPART = al256(WS_BIAS + (size_t)NPAD * 4);
constexpr size_t WS_Q = WS_CPART + 2 * 32 * 256 * 4;
constexpr size_t WS_KC = WS_Q + SZ_TD;
constexpr size_t WS_ZA = WS_KC + 6 * SZ_KV;
constexpr size_t WS_GM = WS_ZA + 5 * SZ_TD;
constexpr size_t WS_GN = WS_GM + 2 * SZ_TD;
constexpr size_t WS_PQK = WS_GN + (size_t)TOK * 256 * 2, WS_PQV = WS_PQK + (size_t)4 * 2048 * 512 * 2;
constexpr size_t WS_KCB = WS_PQV + (size_t)4 * 2048 * 512 * 2, WS_VCB = WS_KCB + 16 * 128 * 128 * 2;
constexpr size_t WS_PARK = WS_VCB + 16 * 128 * 128 * 2;
constexpr size_t WS_SLOTS = WS_PARK + (size_t)256 * 8 * 16384;
constexpr size_t WS_END = WS_SLOTS + (size_t)TOK * 32 * 4;
constexpr int CW_PANEL = 8192;

struct EpiIn {
    static constexpr bool PERM = true, AFTER_DRAIN = false;
    unsigned char* ws; const float* bias;
    __device__ __forceinline__ void load_bias(const Unit& u, int wc, int fq, f32x4 (&bv)[2][2]) const {
        const float* bp = bias + u.pn * BM + wc * 32 + 8 * fq;
#pragma unroll
        for (int bj = 0; bj < 2; ++bj)
#pragma unroll
            for (int n = 0; n < 2; ++n) bv[bj][n] = *(const f32x4*)(bp + bj * HALF + 4 * n);
    }
    __device__ __forceinline__ void operator()(const f32x4 (&acc)[2][2][4][2], const Unit& u, int wr, int wc, int fr, int fq) const {
        const int pn = u.pn;
        size_t off; int ldc, colt, act = 0; float sc = 1.f; bool kcl = false;
        if (pn < 8) { off = WS_Q; ldc = 2048; colt = pn * 256; sc = QSCALE; }
        else if (pn < 20) { const int s = (pn - 8) >> 1; off = WS_KC + (size_t)s * SZ_KV; ldc = 512; colt = ((pn - 8) & 1) * 256; kcl = true; }
        else if (pn < 60) { const int s = (pn - 20) >> 3; off = WS_ZA + (size_t)s * SZ_TD; ldc = 2048; colt = ((pn - 20) & 7) * 256; act = (s == 0 || s == 4) ? 1 : 0; }
        else if (pn < 76) { off = WS_GM; ldc = 4096; colt = (pn - 60) * 256; act = 2; }
        else { off = WS_GN; ldc = 256; colt = 0; act = 2; }
        bf16_t* base = (bf16_t*)(ws + off);
        const int row0 = u.pm * BM + wr * 64 + fr, cl = wc * 32 + 8 * fq, bcol0 = pn * BM + cl;
        if (pn >= 28 && pn < 60) {
            const bool bz = pn >= 44; bf16_t* ob = (bf16_t*)(ws + WS_ZA + (bz ? 2 : 1) * SZ_TD) + 128 * ((pn - 28) & 15) + cl;
#pragma unroll
            for (int ai = 0; ai < 2; ++ai)
#pragma unroll
                for (int m = 0; m < 4; ++m) { const int row = row0 + ai * HALF + m * 16;
                    f32x4 a0 = acc[ai][0][m][0], a1 = acc[ai][0][m][1], c0v = acc[ai][1][m][0], c1v = acc[ai][1][m][1];
                    if (bz) { c0v = (f32x4){silu_f(c0v[0]), silu_f(c0v[1]), silu_f(c0v[2]), silu_f(c0v[3])}; c1v = (f32x4){silu_f(c1v[0]), silu_f(c1v[1]), silu_f(c1v[2]), silu_f(c1v[3])}; }
                    a0 = a0 * c0v; a1 = a1 * c1v;
                    u32x4 w; w.x = pk2(a0[0], a0[1]); w.y = pk2(a0[2], a0[3]); w.z = pk2(a1[0], a1[1]); w.w = pk2(a1[2], a1[3]);
                    *(u32x4*)(ob + (size_t)row * 2048) = w; }
            return;
        }
        if (pn >= 60 && pn < 76) {
            bf16_t* ob = (bf16_t*)(ws + WS_GM) + 128 * (pn - 60) + cl;
#pragma unroll
            for (int ai = 0; ai < 2; ++ai)
#pragma unroll
                for (int m = 0; m < 4; ++m) { const int row = row0 + ai * HALF + m * 16;
                    const f32x4 a0 = acc[ai][0][m][0], a1 = acc[ai][0][m][1], c0v = acc[ai][1][m][0], c1v = acc[ai][1][m][1];
                    float r[8], g[8];
#pragma unroll
                    for (int k = 0; k < 4; ++k) { g[k] = fmaxf(sigm_f(c0v[k]), 1e-30f); g[4 + k] = fmaxf(sigm_f(c1v[k]), 1e-30f); r[k] = sigm_f(a0[k]) * __builtin_amdgcn_rcpf(g[k]); r[4 + k] = sigm_f(a1[k]) * __builtin_amdgcn_rcpf(g[4 + k]); }
                    u32x4 w; w.x = pk2(r[0], r[1]); w.y = pk2(r[2], r[3]); w.z = pk2(r[4], r[5]); w.w = pk2(r[6], r[7]);
                    *(u32x4*)(ob + (size_t)row * 2048) = w;
                    w.x = pk2(g[0], g[1]); w.y = pk2(g[2], g[3]); w.z = pk2(g[4], g[5]); w.w = pk2(g[6], g[7]);
                    *(u32x4*)(ob + (size_t)TOK * 2048 + (size_t)row * 2048) = w; }
            return;
        }
#pragma unroll
        for (int ai = 0; ai < 2; ++ai)
#pragma unroll
            for (int m = 0; m < 4; ++m) { const int row = row0 + ai * HALF + m * 16;
#pragma unroll
                for (int bj = 0; bj < 2; ++bj) { f32x4 v0 = acc[ai][bj][m][0], v1 = acc[ai][bj][m][1];
                    if (act == 1) { v0 = (f32x4){silu_f(v0[0]), silu_f(v0[1]), silu_f(v0[2]), silu_f(v0[3])}; v1 = (f32x4){silu_f(v1[0]), silu_f(v1[1]), silu_f(v1[2]), silu_f(v1[3])}; }
                    else if (act == 2) { v0 = (f32x4){sigm_f(v0[0]), sigm_f(v0[1]), sigm_f(v0[2]), sigm_f(v0[3])}; v1 = (f32x4){sigm_f(v1[0]), sigm_f(v1[1]), sigm_f(v1[2]), sigm_f(v1[3])}; }
                    v0 = v0 * sc; v1 = v1 * sc;
                    u32x4 w; w.x = pk2(v0[0], v0[1]); w.y = pk2(v0[2], v0[3]); w.z = pk2(v1[0], v1[1]); w.w = pk2(v1[2], v1[3]);
                    const int c = colt + cl + bj * HALF;
                    bf16_t* dst;
                    if (kcl) { const int b = row >> 11, s = row & 2047, g = c >> 7, d = c & 127; dst = base + ((size_t)((b * 4 + g) * 2048 + s)) * 128 + d; }
                    else dst = base + (size_t)row * ldc + c;
                    *(u32x4*)dst = w; } }
    }
};
struct EpiPlain {
    static constexpr bool PERM = true, AFTER_DRAIN = false;
    bf16_t* O; int ldc;
    __device__ __forceinline__ void operator()(const f32x4 (&acc)[2][2][4][2], const Unit& u, int wr, int wc, int fr, int fq) const {
        const int row0 = u.pm * BM + wr * 64 + fr, c0 = u.pn * BM + wc * 32 + 8 * fq;
#pragma unroll
        for (int ai = 0; ai < 2; ++ai)
#pragma unroll
            for (int m = 0; m < 4; ++m)
#pragma unroll
                for (int bj = 0; bj < 2; ++bj) { const f32x4 v0 = acc[ai][bj][m][0], v1 = acc[ai][bj][m][1];
                    u32x4 w; w.x = pk2(v0[0], v0[1]); w.y = pk2(v0[2], v0[3]); w.z = pk2(v1[0], v1[1]); w.w = pk2(v1[2], v1[3]);
                    *(u32x4*)(O + (size_t)(row0 + ai * HALF + m * 16) * ldc + c0 + bj * HALF) = w; }
    }
};
template <int MODE> struct EpiY {
    static constexpr bool PERM = true, AFTER_DRAIN = false;
    bf16_t* Y; const bf16_t* GM;
    __device__ __forceinline__ void operator()(const f32x4 (&acc)[2][2][4][2], const Unit& u, int wr, int wc, int fr, int fq) const {
        const int row0 = u.pm * BM + wr * 64 + fr, c0 = u.pn * BM + wc * 32 + 8 * fq;
#pragma unroll
        for (int ai = 0; ai < 2; ++ai)
#pragma unroll
            for (int m = 0; m < 4; ++m)
#pragma unroll
                for (int bj = 0; bj < 2; ++bj) { const size_t row = (size_t)(row0 + ai * HALF + m * 16); const int c = c0 + bj * HALF;
                    const u32x4 g = *(const u32x4*)(GM + row * 4096 + MODE * 2048 + c);
                    f32x4 v0 = acc[ai][bj][m][0], v1 = acc[ai][bj][m][1];
                    v0 = v0 * (f32x4){bflo(g.x), bfhi(g.x), bflo(g.y), bfhi(g.y)}; v1 = v1 * (f32x4){bflo(g.z), bfhi(g.z), bflo(g.w), bfhi(g.w)};
                    u32x4* yp = (u32x4*)(Y + row * 2048 + c);
                    if (MODE == 1) { const u32x4 y = *yp; v0 = v0 + (f32x4){bflo(y.x), bfhi(y.x), bflo(y.y), bfhi(y.y)}; v1 = v1 + (f32x4){bflo(y.z), bfhi(y.z), bflo(y.w), bfhi(y.w)}; }
                    u32x4 w; w.x = pk2(v0[0], v0[1]); w.y = pk2(v0[2], v0[3]); w.z = pk2(v1[0], v1[1]); w.w = pk2(v1[2], v1[3]);
                    *yp = w; }
    }
};
struct EpiYChain {
    static constexpr bool PERM = true, AFTER_DRAIN = false;
    bf16_t* Y; const bf16_t* GM;
    __device__ __forceinline__ bool keep_acc(const Unit& u) const { return u.pm < 32; }
    __device__ __forceinline__ void operator()(f32x4 (&acc)[2][2][4][2], const Unit& u, int wr, int wc, int fr, int fq) const {
        const bool first = u.pm < 32;
        const int row0 = (u.pm & 31) * BM + wr * 64 + fr, c0 = (u.pn & 7) * BM + wc * 32 + 8 * fq;
#pragma unroll
        for (int ai = 0; ai < 2; ++ai) {
            u32x4 gv[4][2];
            const bf16_t* G = GM + (first ? (size_t)0 : (size_t)TOK * 2048);
#pragma unroll
            for (int m = 0; m < 4; ++m)
#pragma unroll
                for (int bj = 0; bj < 2; ++bj) gv[m][bj] = __builtin_nontemporal_load((const u32x4*)(G + (size_t)(row0 + ai * HALF + m * 16) * 2048 + c0 + bj * HALF));
#pragma unroll
            for (int m = 0; m < 4; ++m)
#pragma unroll
                for (int bj = 0; bj < 2; ++bj) { const size_t row = (size_t)(row0 + ai * HALF + m * 16); const int c = c0 + bj * HALF;
                    const u32x4 g1 = gv[m][bj];
                    const f32x4 s0 = {bflo(g1.x), bfhi(g1.x), bflo(g1.y), bfhi(g1.y)}, s1 = {bflo(g1.z), bfhi(g1.z), bflo(g1.w), bfhi(g1.w)};
                    if (first) { acc[ai][bj][m][0] = acc[ai][bj][m][0] * s0; acc[ai][bj][m][1] = acc[ai][bj][m][1] * s1; }
                    else { const f32x4 v0 = acc[ai][bj][m][0] * s0, v1 = acc[ai][bj][m][1] * s1;
                        u32x4 w; w.x = pk2(v0[0], v0[1]); w.y = pk2(v0[2], v0[3]); w.z = pk2(v1[0], v1[1]); w.w = pk2(v1[2], v1[3]);
                        *(u32x4*)(Y + row * 2048 + c) = w; } }
            asm volatile("" ::: "memory");
        }
    }
};
struct EpiOutNorm {
    static constexpr bool PERM = true, AFTER_DRAIN = true;
    const float* x; float* out; const float* fg; float* slots; unsigned* cnt;
    __device__ __forceinline__ void fused(f32x4 (&acc)[2][2][4][2], const Unit& u, int wr, int wc, int fr, int fq, PG8_LAS unsigned char* lds, int wid, int lane) const {
        const int row0 = u.pm * BM + wr * 64 + fr, c0 = u.pn * BM + wc * 32 + 8 * fq;
        f32x4 gv[2][2];
#pragma unroll
        for (int bj = 0; bj < 2; ++bj) { gv[bj][0] = *(const f32x4*)(fg + c0 + bj * HALF); gv[bj][1] = *(const f32x4*)(fg + c0 + bj * HALF + 4); }
#pragma unroll
        for (int ai = 0; ai < 2; ++ai)
#pragma unroll
            for (int m = 0; m < 4; ++m) { float s = 0.f;
#pragma unroll
                for (int bj = 0; bj < 2; ++bj) { const f32x4 a = acc[ai][bj][m][0], b = acc[ai][bj][m][1];
                    s += (a[0] * a[0] + a[1] * a[1]) + (a[2] * a[2] + a[3] * a[3]) + (b[0] * b[0] + b[1] * b[1]) + (b[2] * b[2] + b[3] * b[3]); }
                s += __shfl_xor(s, 16); s += __shfl_xor(s, 32);
                if (fq == 0) __hip_atomic_store(slots + (size_t)(row0 + ai * HALF + m * 16) * 32 + u.pn * 4 + wc, s, __ATOMIC_RELAXED, __HIP_MEMORY_SCOPE_AGENT); }
        asm volatile("s_waitcnt vmcnt(0)" ::: "memory");
        if (lane == 0) __hip_atomic_fetch_add(cnt + 64 * u.pm, 1u, __ATOMIC_RELAXED, __HIP_MEMORY_SCOPE_AGENT);
        if (wid == 0) {
            unsigned sp = 0;
            while ((unsigned)__builtin_amdgcn_readfirstlane(__hip_atomic_load(cnt + 64 * u.pm, __ATOMIC_RELAXED, __HIP_MEMORY_SCOPE_AGENT)) < 64u) { __builtin_amdgcn_s_sleep(2); if (++sp > (1u << 22)) break; }
            __builtin_amdgcn_fence(__ATOMIC_ACQUIRE, "agent");
        }
        asm volatile("s_waitcnt vmcnt(0) lgkmcnt(0)" ::: "memory"); __builtin_amdgcn_s_barrier(); asm volatile("" ::: "memory");
        PG8_LAS float* R = (PG8_LAS float*)lds;
        { const int t = wid * 64 + lane, r = t >> 1, hf = t & 1; const float* sl = slots + (size_t)(u.pm * BM + r) * 32 + hf * 16; float s = 0.f;
#pragma unroll
          for (int k = 0; k < 16; ++k) s += __hip_atomic_load(sl + k, __ATOMIC_RELAXED, __HIP_MEMORY_SCOPE_AGENT);
          s += __shfl_xor(s, 1);
          if (hf == 0) R[r] = 1.0f / sqrtf(s * (1.0f / 2048.0f) + 1e-6f); }
        asm volatile("s_waitcnt lgkmcnt(0)" ::: "memory"); __builtin_amdgcn_s_barrier(); asm volatile("" ::: "memory");
#pragma unroll
        for (int ai = 0; ai < 2; ++ai)
#pragma unroll
            for (int m = 0; m < 4; ++m) { const int rl = ai * HALF + wr * 64 + m * 16 + fr; const float rs = R[rl];
#pragma unroll
                for (int bj = 0; bj < 2; ++bj) { const size_t o = (size_t)(u.pm * BM + rl) * 2048 + c0 + bj * HALF;
                    *(f32x4*)(out + o) = acc[ai][bj][m][0] * rs * gv[bj][0]; *(f32x4*)(out + o + 4) = acc[ai][bj][m][1] * rs * gv[bj][1]; } }
    }
};
template <class E> constexpr bool epi_has_bias = false;
template <> constexpr bool epi_has_bias<EpiIn> = true;
template <class E> __device__ __forceinline__ auto keep_acc_of(const E& e, const Unit& u, int) -> decltype(e.keep_acc(u)) { return e.keep_acc(u); }
template <class E> __device__ __forceinline__ bool keep_acc_of(const E&, const Unit&, long) { return false; }
template <class Epi, class Sched, bool ALIGN_EPI = false, bool SP2 = false>
__device__ __forceinline__ void gemm_phase(PG8_LAS unsigned char* lds, const Gemm g, const Sched& S, const Epi& E, const f32x4 (*acc0)[2][4][2] = nullptr) {
    const int tid = threadIdx.x, wid = __builtin_amdgcn_readfirstlane(tid >> 6), lane = tid & 63, wr = wid >> 2, wc = wid & 3, fr = lane & 15, fq = lane >> 4;
    const int K = g.K, nt = K / BK; const int lda = g.lda ? g.lda : K, ldb = g.ldb ? g.ldb : K;
    unsigned voffA[2], voffB[2];
#pragma unroll
    for (int i = 0; i < 2; ++i) { int R, C; stage_rc(tid * 16 + i * 8192, R, C); const int Rb = Epi::PERM ? ((R & ~31) + perm32(R & 31)) : R;
        voffA[i] = (unsigned)(R * lda + C) * 2u; voffB[i] = (unsigned)(Rb * ldb + C) * 2u; }
    const size_t kstep = (size_t)(BK * 2);
    const size_t hstepA = (size_t)HALF * lda * 2, hstepB = (size_t)HALF * ldb * 2;
    const size_t tstepA = 2 * hstepA, tstepB = 2 * hstepB;
    const unsigned ldsw = (unsigned)wid * 1024u;
    const int aoff = lds_byte(wr * 64 + fr, fq * 8), boff = lds_byte(wc * 32 + fr, fq * 8);
#define PG8_SA(b, h) (((b) * 2 + (h)) * HTB)
#define PG8_SB(b, h) ((4 + (b) * 2 + (h)) * HTB)
#define PG8_STAGE(bufoff, gbase, voff) do { _Pragma("unroll") for (int _i = 0; _i < 2; ++_i) \
        __builtin_amdgcn_global_load_lds((const unsigned*)((const char*)(gbase) + (voff)[_i]), (PG8_LAS unsigned*)(lds + (bufoff) + ldsw + _i * 8192), 16, 0, 0); } while (0)
#define PG8_LDA(dst, b, h) do { _Pragma("unroll") for (int m = 0; m < 4; ++m) _Pragma("unroll") for (int k = 0; k < 2; ++k) dst[m][k] = *(const PG8_LAS bf16x8*)(lds + PG8_SA(b, h) + aoff + m * 2048 + k * 1024); } while (0)
#define PG8_LDB(dst, b, h) do { _Pragma("unroll") for (int n = 0; n < 2; ++n) _Pragma("unroll") for (int k = 0; k < 2; ++k) dst[n][k] = *(const PG8_LAS bf16x8*)(lds + PG8_SB(b, h) + boff + n * 2048 + k * 1024); } while (0)
#define PG8_MMA(ai, bj, At, Bt) do { __builtin_amdgcn_s_setprio(1); _Pragma("unroll") for (int m = 0; m < 4; ++m) _Pragma("unroll") for (int n = 0; n < 2; ++n) _Pragma("unroll") for (int k = 0; k < 2; ++k) \
        acc[ai][bj][m][n] = __builtin_amdgcn_mfma_f32_16x16x32_bf16(Bt[n][k], At[m][k], acc[ai][bj][m][n], 0, 0, 0); __builtin_amdgcn_s_setprio(0); } while (0)
#define PG8_WAIT_V(n) asm volatile("s_waitcnt vmcnt(" #n ")" ::: "memory")
#define PG8_WAIT_L(n) asm volatile("s_waitcnt lgkmcnt(" #n ")" ::: "memory")
#define PG8_BAR __builtin_amdgcn_s_barrier()
#define PG8_SCHED __builtin_amdgcn_sched_barrier(0)
    Unit cur, nxt; int ui = 0;
    if (!S.next(0, cur)) return;
    f32x4 acc[2][2][4][2];
#pragma unroll
    for (int a = 0; a < 2; ++a)
#pragma unroll
        for (int b = 0; b < 2; ++b)
#pragma unroll
            for (int m = 0; m < 4; ++m)
#pragma unroll
                for (int n = 0; n < 2; ++n) acc[a][b][m][n] = acc0 ? acc0[a][b][m][n] : (f32x4){0.f, 0.f, 0.f, 0.f};
    f32x4 bnx[2][2];
    if constexpr (epi_has_bias<Epi>) { E.load_bias(cur, wc, fq, bnx);
#pragma unroll
        for (int a = 0; a < 2; ++a)
#pragma unroll
            for (int b = 0; b < 2; ++b)
#pragma unroll
                for (int m = 0; m < 4; ++m)
#pragma unroll
                    for (int n = 0; n < 2; ++n) acc[a][b][m][n] = bnx[b][n]; }
    bf16x8 At[4][2], B0[2][2], B1[2][2];
    const char* cA = (const char*)g.A + (size_t)cur.pm * tstepA; const char* cB = (const char*)g.Bt + (size_t)cur.pn * tstepB;
    S.a_ready(cur);
    if constexpr (SP2) {
        PG8_STAGE(PG8_SB(0, 0), cB, voffB); PG8_STAGE(PG8_SB(0, 1), cB + hstepB, voffB); PG8_STAGE(PG8_SA(0, 0), cA, voffA); PG8_STAGE(PG8_SA(0, 1), cA + hstepA, voffA);
        if (wr == 1) PG8_BAR;
        PG8_WAIT_V(2); PG8_BAR;
        PG8_STAGE(PG8_SB(1, 0), cB + kstep, voffB); PG8_STAGE(PG8_SA(1, 0), cA + kstep, voffA); PG8_STAGE(PG8_SB(1, 1), cB + hstepB + kstep, voffB);
        PG8_WAIT_V(6); PG8_BAR;
    } else {
        PG8_STAGE(PG8_SB(0, 0), cB, voffB); PG8_STAGE(PG8_SA(0, 0), cA, voffA); PG8_STAGE(PG8_SB(0, 1), cB + hstepB, voffB); PG8_STAGE(PG8_SA(0, 1), cA + hstepA, voffA);
        if (wr == 1) PG8_BAR;
        PG8_WAIT_V(4); PG8_BAR;
        PG8_STAGE(PG8_SB(1, 0), cB + kstep, voffB); PG8_STAGE(PG8_SA(1, 0), cA + kstep, voffA); PG8_STAGE(PG8_SB(1, 1), cB + hstepB + kstep, voffB);
        PG8_WAIT_V(6); PG8_BAR;
    }
    for (;;) {
        const bool has_next = S.next(ui + 1, nxt);
        const char* nA = has_next ? (const char*)g.A + (size_t)nxt.pm * tstepA : cA; const char* nB = has_next ? (const char*)g.Bt + (size_t)nxt.pn * tstepB : cB;
        for (int t = 0; t < nt; t += 2) {
            const bool last = (t == nt - 2);
            const char* a1 = cA + (size_t)(t + 1) * kstep;
            const char* a2 = last ? nA : cA + (size_t)(t + 2) * kstep; const char* b2 = last ? nB : cB + (size_t)(t + 2) * kstep;
            const char* a3 = a2 + kstep; const char* b3 = b2 + kstep;
            if (last && has_next) S.a_ready(nxt);
            if constexpr (SP2) {
            PG8_LDB(B0, 0, 0); PG8_LDB(B1, 0, 1); PG8_SCHED; PG8_LDA(At, 0, 0); PG8_STAGE(PG8_SA(1, 1), a1 + hstepA, voffA);
            PG8_WAIT_V(8); PG8_WAIT_L(0); PG8_BAR; PG8_MMA(0, 0, At, B0); PG8_MMA(0, 1, At, B1); PG8_BAR; PG8_SCHED;
            PG8_LDA(At, 0, 1); PG8_STAGE(PG8_SB(0, 0), b2, voffB); PG8_STAGE(PG8_SB(0, 1), b2 + hstepB, voffB); PG8_STAGE(PG8_SA(0, 0), a2, voffA);
            PG8_WAIT_V(8); PG8_WAIT_L(0); PG8_BAR; PG8_MMA(1, 0, At, B0); PG8_MMA(1, 1, At, B1); PG8_BAR; PG8_SCHED;
            PG8_LDB(B0, 1, 0); PG8_LDB(B1, 1, 1); PG8_SCHED; PG8_LDA(At, 1, 0); PG8_STAGE(PG8_SA(0, 1), a2 + hstepA, voffA);
            PG8_WAIT_V(8); PG8_WAIT_L(0); PG8_BAR; PG8_MMA(0, 0, At, B0); PG8_MMA(0, 1, At, B1); PG8_BAR; PG8_SCHED;
            PG8_LDA(At, 1, 1); PG8_STAGE(PG8_SB(1, 0), b3, voffB); PG8_STAGE(PG8_SB(1, 1), b3 + hstepB, voffB); PG8_STAGE(PG8_SA(1, 0), a3, voffA);
            PG8_WAIT_V(8); PG8_WAIT_L(0); PG8_BAR; PG8_MMA(1, 0, At, B0); PG8_MMA(1, 1, At, B1); PG8_BAR; PG8_SCHED;
            } else {
            PG8_LDB(B0, 0, 0); PG8_SCHED; PG8_LDA(At, 0, 0); PG8_STAGE(PG8_SA(1, 1), a1 + hstepA, voffA);
            PG8_WAIT_L(8); PG8_BAR; PG8_WAIT_L(0); PG8_MMA(0, 0, At, B0); PG8_BAR; PG8_SCHED;
            PG8_LDB(B1, 0, 1); PG8_STAGE(PG8_SB(0, 0), b2, voffB);
            PG8_BAR; PG8_WAIT_L(0); PG8_MMA(0, 1, At, B1); PG8_BAR;
            PG8_LDA(At, 0, 1); PG8_STAGE(PG8_SA(0, 0), a2, voffA);
            PG8_BAR; PG8_WAIT_L(0); PG8_MMA(1, 0, At, B0); PG8_BAR; PG8_SCHED;
            PG8_STAGE(PG8_SB(0, 1), b2 + hstepB, voffB);
            PG8_WAIT_V(6); PG8_BAR; PG8_MMA(1, 1, At, B1); PG8_BAR;
            PG8_LDB(B0, 1, 0); PG8_SCHED; PG8_LDA(At, 1, 0); PG8_STAGE(PG8_SA(0, 1), a2 + hstepA, voffA);
            PG8_WAIT_L(8); PG8_BAR; PG8_WAIT_L(0); PG8_MMA(0, 0, At, B0); PG8_BAR; PG8_SCHED;
            PG8_LDB(B1, 1, 1); PG8_STAGE(PG8_SB(1, 0), b3, voffB);
            PG8_BAR; PG8_WAIT_L(0); PG8_MMA(0, 1, At, B1); PG8_BAR;
            PG8_LDA(At, 1, 1); PG8_STAGE(PG8_SA(1, 0), a3, voffA);
            PG8_BAR; PG8_WAIT_L(0); PG8_MMA(1, 0, At, B0); PG8_BAR; PG8_SCHED;
            PG8_STAGE(PG8_SB(1, 1), b3 + hstepB, voffB);
            PG8_WAIT_V(6); PG8_BAR; PG8_MMA(1, 1, At, B1); PG8_BAR;
            }
        }
        if constexpr (ALIGN_EPI) { if (wr == 0) PG8_BAR; }
        if constexpr (epi_has_bias<Epi>) { if (has_next) E.load_bias(nxt, wc, fq, bnx); }
        if constexpr (!Epi::AFTER_DRAIN) { E(acc, cur, wr, wc, fr, fq); S.done(cur); }
        if (!has_next) break;
        if (!keep_acc_of(E, cur, 0)) {
#pragma unroll
        for (int a = 0; a < 2; ++a)
#pragma unroll
            for (int b = 0; b < 2; ++b)
#pragma unroll
                for (int m = 0; m < 4; ++m)
#pragma unroll
                    for (int n = 0; n < 2; ++n) { if constexpr (epi_has_bias<Epi>) acc[a][b][m][n] = bnx[b][n]; else acc[a][b][m][n] = (f32x4){0.f, 0.f, 0.f, 0.f}; }
        }
        cur = nxt; cA = nA; cB = nB; ++ui;
        if constexpr (ALIGN_EPI) { if (wr == 1) PG8_BAR; }
    }
    PG8_WAIT_V(0);
    if constexpr (!ALIGN_EPI) { if (wr == 0) PG8_BAR; }
    PG8_BAR;
    if constexpr (Epi::AFTER_DRAIN) { E.fused(acc, cur, wr, wc, fr, fq, lds, wid, lane); S.done(cur); }
#undef PG8_SA
#undef PG8_SB
#undef PG8_STAGE
#undef PG8_LDA
#undef PG8_LDB
#undef PG8_MMA
#undef PG8_WAIT_V
#undef PG8_WAIT_L
#undef PG8_BAR
#undef PG8_SCHED
}
}

#define LAS __attribute__((address_space(3)))
#define DI __device__ __forceinline__
using pg8::bf16_t; using pg8::pk2; using pg8::bflo; using pg8::bfhi; using pg8::silu_f;
using pg8::TOK; using pg8::DM; using pg8::NPAD;
typedef short bf16x8 __attribute__((ext_vector_type(8)));
typedef short s16x4 __attribute__((ext_vector_type(4)));
typedef short v4i16_t __attribute__((ext_vector_type(4)));
typedef float f32x16 __attribute__((ext_vector_type(16)));
typedef float f32x4 __attribute__((ext_vector_type(4)));
typedef unsigned u32x4 __attribute__((ext_vector_type(4)));
typedef unsigned u32x2 __attribute__((ext_vector_type(2)));
#define LDS_WAIT() asm volatile("s_waitcnt lgkmcnt(0)" ::: "memory")
DI float bf2f(bf16_t v) { return __uint_as_float((unsigned)v << 16); }
DI float wave_sum(float v) {
#pragma unroll
    for (int o = 1; o < 64; o <<= 1) v += __shfl_xor(v, o);
    return v;
}
DI float ex2(float v) { return __builtin_amdgcn_exp2f(v); }

DI int win_src_col(int n) {
    if (n < 5120) return n;
    if (n < 7168) return n + 48;
    if (n < 15360) { const int t = (n - 7168) >> 8, j = (n - 7168) & 255, hf = j >> 7, ch = 128 * (t & 15) + (j & 127); return (t < 16 ? (hf ? 9264 : 7216) : (hf ? 13360 : 11312)) + ch; }
    if (n < 19456) { const int t = (n - 15360) >> 8, j = (n - 15360) & 255; return 15408 + ((j >> 7) ? 2048 : 0) + 128 * t + (j & 127); }
    return n < 19504 ? n - 14336 : -1; }
DI void tr_item(const float* __restrict__ W, int Nsrc, int srccol4, bf16_t* WT, int Kdst, int n0dst, int k0, LAS float* scr, int lane) {
    const int c4 = 4 * (lane & 15);
    f32x4 v[16];
#pragma unroll
    for (int i = 0; i < 16; ++i) { v[i] = (f32x4){0.f, 0.f, 0.f, 0.f}; if (srccol4 >= 0) v[i] = __builtin_nontemporal_load((const f32x4*)(W + (size_t)(k0 + 4 * i + (lane >> 4)) * Nsrc + srccol4)); }
#pragma unroll
    for (int i = 0; i < 16; ++i) { LAS float* d = scr + (4 * i + (lane >> 4)) * 65 + c4; d[0] = v[i].x; d[1] = v[i].y; d[2] = v[i].z; d[3] = v[i].w; }
    LDS_WAIT();
    const int c = lane & 7;
#pragma unroll
    for (int x = 0; x < 8; ++x) { const int n = 8 * x + (lane >> 3); const LAS float* s = scr + (8 * c) * 65 + n;
        u32x4 o; o.x = pk2(s[0 * 65], s[1 * 65]); o.y = pk2(s[2 * 65], s[3 * 65]); o.z = pk2(s[4 * 65], s[5 * 65]); o.w = pk2(s[6 * 65], s[7 * 65]);
        *(u32x4*)(WT + (size_t)(n0dst + n) * Kdst + k0 + 8 * c) = o; }
    LDS_WAIT();
}
struct Args { const float* in[16]; float* out; unsigned char* ws; int ph_lo, ph_hi, ph_rep, pad; };

template <int PART>
DI void p0_phase(LAS unsigned char* lds, const Args& a, int fi, int nf, int tid, int lane, int wave) {
    unsigned char* ws = a.ws;
    LAS float* scr = (LAS float*)(lds + wave * 16640);
    const int gw = fi * 8 + wave, NGW = nf * 8;
    constexpr int I_WIN = 32 * 308, I_SQ = 32 * 32, I_W1 = 256;
    const int l4 = 4 * (lane & 15);
    if (PART == 0) {
        for (int r = gw; r < I_WIN; r += NGW) { const int kb = r & 31, nb = r >> 5;
            tr_item(a.in[2], 19504, win_src_col(nb * 64 + l4), (bf16_t*)(ws + pg8::WS_WIN), 2048, nb * 64, kb * 64, scr, lane); }
        for (int m = gw; m < TOK; m += NGW) {
            const f32x4* xr = (const f32x4*)(a.in[0] + (size_t)m * DM) + lane; const f32x4* gr = (const f32x4*)a.in[1] + lane;
            f32x4 v[8]; float s = 0.f;
#pragma unroll
            for (int j = 0; j < 8; ++j) { v[j] = __builtin_nontemporal_load(xr + 64 * j); s += (v[j].x * v[j].x + v[j].y * v[j].y) + (v[j].z * v[j].z + v[j].w * v[j].w); }
            const float rs = 1.0f / sqrtf(wave_sum(s) * (1.f / DM) + 1e-6f);
            u32x2* o8 = (u32x2*)((bf16_t*)(ws + pg8::WS_HN) + (size_t)m * DM) + lane;
#pragma unroll
            for (int j = 0; j < 8; ++j) { const f32x4 g = gr[64 * j]; u32x2 w; w.x = pk2(v[j].x * rs * g.x, v[j].y * rs * g.y); w.y = pk2(v[j].z * rs * g.z, v[j].w * rs * g.w); o8[64 * j] = w; }
        }
        { float* bp = (float*)(ws + pg8::WS_BIAS);
          for (int n = fi * 512 + tid; n < NPAD; n += nf * 512) { const int sc = win_src_col(n); bp[n] = sc >= 0 ? a.in[3][sc] : 0.f; } }
    } else {
        for (int r0 = gw; r0 < 3 * I_SQ + 2 * I_W1; r0 += NGW) { int r = r0;
            if (r < 3 * I_SQ) { const int w = r / I_SQ, r2 = r % I_SQ, kb = r2 & 31, nb = r2 >> 5;
                tr_item(a.in[12 + w], 2048, nb * 64 + l4, (bf16_t*)(ws + pg8::WS_PAT + (size_t)w * pg8::SZ_W), 2048, nb * 64, kb * 64, scr, lane); continue; }
            r -= 3 * I_SQ;
            { const int which = r / I_W1, r2 = r % I_W1, half = r2 / 128, r3 = r2 % 128, kb = r3 & 31, nb = r3 >> 5;
              tr_item(a.in[which ? 8 : 5] + (size_t)half * 2048 * 256, 256, nb * 64 + l4, (bf16_t*)(ws + (which ? pg8::WS_W1V : pg8::WS_W1K)), 2048, half * 256 + nb * 64, kb * 64, scr, lane); } }
        for (int job = fi * 2 + (tid >> 8); job < 64; job += nf * 2) { const int which = job >> 5, chunk = job & 31, j = tid & 255;
            const float* pe = a.in[which ? 7 : 4] + chunk * 128; const float* w1 = a.in[which ? 8 : 5] + (size_t)chunk * 128 * 256 + j; float s = 0.f;
#pragma unroll 32
            for (int r = 0; r < 128; ++r) s += pe[r] * w1[(size_t)r * 256];
            ((float*)(ws + pg8::WS_CPART))[(which * 32 + chunk) * 256 + j] = s; }
    }
}

DI void conv_run(unsigned char* ws, const float* cw, const float* cbias, int run, int tid) {
    const int cg8 = tid & 255, t0 = run * 8, ch = cg8 * 8;
    const bf16_t* V = (const bf16_t*)(ws + pg8::WS_ZA + 1 * pg8::SZ_TD); const bf16_t* GT = (const bf16_t*)(ws + pg8::WS_ZA + 2 * pg8::SZ_TD);
    bf16_t* A2 = (bf16_t*)(ws + pg8::WS_A2);
    float w0[8], w1[8], w2[8], bb[8], v1[8], v2[8];
#pragma unroll
    for (int k = 0; k < 8; ++k) { w0[k] = cw[ch + k]; w1[k] = cw[2048 + ch + k]; w2[k] = cw[4096 + ch + k]; bb[k] = cbias[ch + k]; v1[k] = 0.f; v2[k] = 0.f; }
    auto unpack = [](const u32x4 w, float (&f)[8]) { f[0] = bflo(w.x); f[1] = bfhi(w.x); f[2] = bflo(w.y); f[3] = bfhi(w.y); f[4] = bflo(w.z); f[5] = bfhi(w.z); f[6] = bflo(w.w); f[7] = bfhi(w.w); };
    u32x4 vv[8], gv[8];
#pragma unroll
    for (int tt = 0; tt < 8; ++tt) { const size_t o = (size_t)(t0 + tt) * DM + ch; vv[tt] = *(const u32x4*)(V + o); gv[tt] = __builtin_nontemporal_load((const u32x4*)(GT + o)); }
    if ((t0 & 2047) != 0) { unpack(*(const u32x4*)(V + (size_t)(t0 - 2) * DM + ch), v2); unpack(*(const u32x4*)(V + (size_t)(t0 - 1) * DM + ch), v1); }
#pragma unroll
    for (int tt = 0; tt < 8; ++tt) { const size_t o = (size_t)(t0 + tt) * DM + ch;
        float v[8], g[8], r[8];
        unpack(vv[tt], v); unpack(gv[tt], g);
#pragma unroll
        for (int k = 0; k < 8; ++k) { const float y = w0[k] * v2[k] + w1[k] * v1[k] + w2[k] * v[k] + bb[k]; r[k] = g[k] * y; v2[k] = v1[k]; v1[k] = v[k]; }
        u32x4 w; w.x = pk2(r[0], r[1]); w.y = pk2(r[2], r[3]); w.z = pk2(r[4], r[5]); w.w = pk2(r[6], r[7]);
        *(u32x4*)(A2 + o) = w; }
}

DI void p3_phase(LAS unsigned char* lds, unsigned char* ws, const float* w2k, const float* w2v, int bx, int G, int tid) {
    LAS float* cst = (LAS float*)lds;
    LAS float* hid = cst + 256;
    for (int item = bx; item < 256; item += G) {
        const int which = item >> 7, rem = item & 127, bg = rem >> 3, n0 = (rem & 7) * 16;
        if (tid < 256) { const float* cp = (const float*)(ws + pg8::WS_CPART) + which * 32 * 256 + tid; float s = 0.f;
#pragma unroll 8
            for (int k = 0; k < 32; ++k) s += cp[k * 256];
            cst[tid] = s; }
        __syncthreads();
        const bf16_t* PQ = (const bf16_t*)(ws + (which ? pg8::WS_PQV : pg8::WS_PQK));
#pragma unroll
        for (int x = 0; x < 8; ++x) { const int e = tid + 512 * x, r = e >> 8, j = e & 255, n = n0 + r; float hv = 0.f;
            if (n < 127) { float s = cst[j];
#pragma unroll
                for (int sp = 0; sp < 4; ++sp) s += bf2f(PQ[(size_t)sp * 2048 * 512 + (size_t)(bg * 128 + n) * 512 + j]) + bf2f(PQ[(size_t)sp * 2048 * 512 + (size_t)(bg * 128 + n + 1) * 512 + 256 + j]);
                hv = silu_f(s); }
            hid[j * 16 + r] = hv; }
        __syncthreads();
        const int d = tid & 127, rg = tid >> 7; const float* w2 = (which ? w2v : w2k) + d; f32x4 acc = {0.f, 0.f, 0.f, 0.f};
#pragma unroll 16
        for (int j = 0; j < 256; ++j) acc += *(const LAS f32x4*)(hid + j * 16 + 4 * rg) * w2[j * 128];
        bf16_t* ob = (bf16_t*)(ws + (which ? pg8::WS_VCB : pg8::WS_KCB)) + (size_t)(bg * 128 + n0 + 4 * rg) * 128 + d;
#pragma unroll
        for (int k = 0; k < 4; ++k) ob[k * 128] = (bf16_t)(pk2((n0 + 4 * rg + k) < 127 ? acc[k] : 0.f, 0.f) & 0xffffu);
        __syncthreads();
    }
}

DI void p8_phase(float* out, const float* fg, int vcu, int G, int lane, int wave) {
    for (int m = vcu * 8 + wave; m < TOK; m += G * 8) {
        f32x4* xr = (f32x4*)(out + (size_t)m * DM) + lane; const f32x4* gr = (const f32x4*)fg + lane;
        f32x4 v[8]; float s = 0.f;
#pragma unroll
        for (int j = 0; j < 8; ++j) { v[j] = xr[64 * j]; s += (v[j].x * v[j].x + v[j].y * v[j].y) + (v[j].z * v[j].z + v[j].w * v[j].w); }
        const float rs = 1.0f / sqrtf(wave_sum(s) * (1.f / DM) + 1e-6f);
#pragma unroll
        for (int j = 0; j < 8; ++j) xr[64 * j] = v[j] * rs * gr[64 * j];
    }
}
namespace att {
constexpr int KP = 272, VP = 320, KBUF = 64 * KP, VBUF = 64 * VP;
constexpr int L_K = 0, L_V = 2 * KBUF, L_IMPH = L_V + 2 * VBUF, L_IMP = L_IMPH + 4 * 64 * 33 * 4  , L_PARK = L_IMPH  , L_MASK = 146688, L_END = L_MASK + 256;
static_assert(L_IMP + 8192 <= L_PARK + 65536 && L_PARK + 65536 <= L_MASK, "attention LDS map");
constexpr float NEG = -1e30f;
DI float xhalf(float v) { const auto rr = __builtin_amdgcn_permlane32_swap(__float_as_uint(v), __float_as_uint(v), false, false); return __uint_as_float((threadIdx.x & 32) ? rr[0] : rr[1]); }
DI float fadd_s(float a, float b) { float r; asm("v_add_f32_e32 %0, %1, %2" : "=v"(r) : "v"(a), "v"(b)); return r; }
DI int crow(int i, int h) { return (i & 3) + 8 * (i >> 2) + 4 * h; }
#define MFMA32(a, b, c) __builtin_amdgcn_mfma_f32_32x32x16_bf16((a), (b), (c), 0, 0, 0)
DI s16x4 vtr(const LAS unsigned char* p) { return __builtin_bit_cast(s16x4, __builtin_amdgcn_ds_read_tr16_b64_v4i16((LAS v4i16_t*)p)); }
DI bf16x8 pack8(const f32x16& p, int s8) {
    u32x4 w; w.x = pk2(p[s8 + 0], p[s8 + 1]); w.y = pk2(p[s8 + 2], p[s8 + 3]); w.z = pk2(p[s8 + 4], p[s8 + 5]); w.w = pk2(p[s8 + 6], p[s8 + 7]); return __builtin_bit_cast(bf16x8, w); }
DI void pv_step(f32x16 (&o)[4], const LAS unsigned char* vb, const bf16x8 pk) {
#pragma unroll
    for (int d = 0; d < 4; ++d) { const s16x4 lo = vtr(vb + d * 64), hi = vtr(vb + d * 64 + 8 * VP);
        const bf16x8 vf = __builtin_shufflevector(lo, hi, 0, 1, 2, 3, 4, 5, 6, 7); o[d] = MFMA32(vf, pk, o[d]); }
    __builtin_amdgcn_sched_barrier(0);
}

DI void pv_nobar(f32x16 (&o)[4], const LAS unsigned char* vb, const bf16x8 pk) {
#pragma unroll
    for (int d = 0; d < 4; ++d) { const s16x4 lo = vtr(vb + d * 64), hi = vtr(vb + d * 64 + 8 * VP);
        const bf16x8 vf = __builtin_shufflevector(lo, hi, 0, 1, 2, 3, 4, 5, 6, 7); o[d] = MFMA32(vf, pk, o[d]); }
}
template <int BR>
DI void flash(LAS unsigned char* lds, const bf16_t* __restrict__ Kg, const bf16_t* __restrict__ Vg, int c, const bf16x8 (&q)[8], f32x16 (&o)[4], float& lsum, unsigned selmask, int tokoff, int lane, int tid, u32x4& fk0, u32x4& fk1, u32x4& fv0, u32x4& fv1, const bf16_t* __restrict__ Kn, const bf16_t* __restrict__ Vn, const char* zsrc, u32x4 (&z)[8]) {
    const int h = lane >> 5, r32 = lane & 31;
    const int jlo = (BR == 1) ? 0 : (c > 8 ? c - 8 : 0);
    const int ntiles = c - jlo + 1;
    const int key0 = tid >> 4, part = tid & 15;
    u32x4 r0, r1, r2, r3;
    const unsigned goff = (unsigned)tid * 16u;
    const unsigned kdo = (unsigned)(key0 * KP + part * 16), vdo = (unsigned)(key0 * VP + part * 16);
#define GLOADX(P, j) do { const char* p_ = (const char*)(P) + (size_t)(j) * 16384; r0 = *(const u32x4*)(p_ + goff); r1 = *(const u32x4*)(p_ + 8192 + goff); } while (0)
#define LSTOREK(buf) do { LAS unsigned char* d_ = lds + L_K + (buf) * KBUF + kdo; *(LAS u32x4*)d_ = r0; *(LAS u32x4*)(d_ + 32 * KP) = r1; } while (0)
#define GLOADV(P, j) do { const char* p_ = (const char*)(P) + (size_t)(j) * 16384; r2 = *(const u32x4*)(p_ + goff); r3 = *(const u32x4*)(p_ + 8192 + goff); } while (0)
#define LSTOREV(buf) do { LAS unsigned char* d_ = lds + L_V + (buf) * VBUF + vdo; *(LAS u32x4*)d_ = r2; *(LAS u32x4*)(d_ + 32 * VP) = r3; } while (0)
#define KRD(dst, kb_, pr) do { dst[0] = *(const LAS bf16x8*)((kb_) + (2 * (pr)) * 32); dst[1] = *(const LAS bf16x8*)((kb_) + 32 * KP + (2 * (pr)) * 32); \
        dst[2] = *(const LAS bf16x8*)((kb_) + (2 * (pr) + 1) * 32); dst[3] = *(const LAS bf16x8*)((kb_) + 32 * KP + (2 * (pr) + 1) * 32); } while (0)
#define KMM(src, pr) do { p0 = MFMA32(src[0], q[2 * (pr)], p0); p1 = MFMA32(src[1], q[2 * (pr)], p1); p0 = MFMA32(src[2], q[2 * (pr) + 1], p0); p1 = MFMA32(src[3], q[2 * (pr) + 1], p1); } while (0)
#define SB0() __builtin_amdgcn_sched_barrier(0)
#define QKT(buf) do { const LAS unsigned char* kb_ = lds + L_K + (buf) * KBUF + r32 * KP + h * 16; bf16x8 ka[4], kb2[4]; \
        KRD(ka, kb_, 0); SB0(); \
        KRD(kb2, kb_, 1); p0 = MFMA32(ka[0], q[0], cin); p1 = MFMA32(ka[1], q[0], cin); p0 = MFMA32(ka[2], q[1], p0); p1 = MFMA32(ka[3], q[1], p1); SB0(); \
        KRD(ka, kb_, 2); KMM(kb2, 1); SB0(); \
        KRD(kb2, kb_, 3); KMM(ka, 2); SB0(); \
        KMM(kb2, 3); SB0(); } while (0)
    const int vlane = (4 * h + ((lane & 15) >> 2)) * VP + ((lane >> 4) & 1) * 32 + (lane & 3) * 8;
    f32x16 p0, p1, cin; bf16x8 pk0, pk1, pk2_, pk3;
    float mref, l;
    const bool lagw = __builtin_amdgcn_readfirstlane(tid) >= 256;
    if (lagw) __builtin_amdgcn_s_setprio(1);
    r0 = fk0; r1 = fk1; LSTOREK(0); r2 = fv0; r3 = fv1; LSTOREV(0);
#pragma unroll
    for (int d = 0; d < 4; ++d)
#pragma unroll
        for (int i = 0; i < 16; ++i) o[d][i] = 0.f;
    __syncthreads();
    { const bool more = ntiles > 1;
      if (more) GLOADX(Kg, c - 1);
#pragma unroll
      for (int i = 0; i < 16; ++i) cin[i] = 0.f;
      QKT(0);
      float rm = NEG;
#pragma unroll
      for (int i = 0; i < 16; ++i) { const int k0 = crow(i, h), k1 = k0 + 32;
          p0[i] = (k0 <= tokoff) ? p0[i] : NEG; p1[i] = (k1 <= tokoff) ? p1[i] : NEG; rm = fmaxf(fmaxf(rm, p0[i]), p1[i]); }
      rm = fmaxf(rm, xhalf(rm));
      mref = rm; float rs = 0.f;
#pragma unroll
      for (int i = 0; i < 16; ++i) { p0[i] = ex2(p0[i] - rm); p1[i] = ex2(p1[i] - rm); rs += p0[i] + p1[i]; }
      l = rs;
      pk0 = pack8(p0, 0); pk1 = pack8(p0, 8); pk2_ = pack8(p1, 0); pk3 = pack8(p1, 8);
      if (BR == 2) {
#pragma unroll
          for (int i = 0; i < 16; ++i) cin[i] = -mref; }
      if (more) LSTOREK(1);
      __syncthreads(); }
#pragma clang loop unroll(disable)
    for (int t = 1; t < ntiles; ++t) {
        const int j = c - t, kbuf = t & 1;
        const bool more = (t + 1 < ntiles);
        if (more) GLOADX(Kg, j - 1);
        GLOADV(Vg, j);
        if (BR == 1) { const float ci = ((selmask >> j) & 1u) ? -mref : NEG;
#pragma unroll
            for (int i = 0; i < 16; ++i) cin[i] = ci; }
        QKT(kbuf);
        if (BR == 2 && j == c - 8) {
#pragma unroll
            for (int i = 0; i < 16; ++i) { const int k0 = crow(i, h), k1 = k0 + 32; p0[i] = (k0 > tokoff) ? p0[i] : NEG; p1[i] = (k1 > tokoff) ? p1[i] : NEG; }
        }
        SB0();
        float rs0 = 0.f, rs1 = 0.f;
        const LAS unsigned char* vb = lds + L_V + (kbuf ^ 1) * VBUF + vlane;
#define SMQ(k) do { _Pragma("unroll") for (int i = 4 * (k); i < 4 * (k) + 4; ++i) { p0[i] = ex2(p0[i]); p1[i] = ex2(p1[i]); rs0 = fadd_s(rs0, p0[i]); rs1 = fadd_s(rs1, p1[i]); } } while (0)
#define VRD(lo_, hi_, s_) do { _Pragma("unroll") for (int d = 0; d < 4; ++d) { lo_[d] = vtr(vb + (16 * (s_)) * VP + d * 64); hi_[d] = vtr(vb + (16 * (s_) + 8) * VP + d * 64); } } while (0)
#define VMM(lo_, hi_, pk_) do { _Pragma("unroll") for (int d = 0; d < 4; ++d) o[d] = MFMA32(__builtin_shufflevector(lo_[d], hi_[d], 0, 1, 2, 3, 4, 5, 6, 7), pk_, o[d]); } while (0)
        { s16x4 la[4], ha[4];
          VRD(la, ha, 0); SMQ(0); VMM(la, ha, pk0); SB0();
          VRD(la, ha, 1); SMQ(1); VMM(la, ha, pk1); SB0();
          VRD(la, ha, 2); SMQ(2); VMM(la, ha, pk2_); SB0();
          VRD(la, ha, 3); SMQ(3); VMM(la, ha, pk3); SB0(); }
#undef SMQ
        float rs = rs0 + rs1;
        if (__any(rs > 512.0f)) {
            float me = fmaxf(p0[0], p1[0]);
#pragma unroll
            for (int i = 1; i < 16; ++i) me = fmaxf(fmaxf(me, p0[i]), p1[i]);
            me = fmaxf(me, xhalf(me));
            const bool grow = me > 256.0f; const float delta = grow ? __builtin_amdgcn_logf(me) : 0.f, alpha = grow ? __builtin_amdgcn_rcpf(me) : 1.f; mref += delta; l *= alpha; rs *= alpha;
#pragma unroll
            for (int i = 0; i < 16; ++i) { p0[i] *= alpha; p1[i] *= alpha; }
#pragma unroll
            for (int d = 0; d < 4; ++d)
#pragma unroll
                for (int i = 0; i < 16; ++i) o[d][i] *= alpha;
            if (BR == 2) {
#pragma unroll
                for (int i = 0; i < 16; ++i) cin[i] = -mref; }
        }
        l += rs;
        pk0 = pack8(p0, 0); pk1 = pack8(p0, 8); pk2_ = pack8(p1, 0); pk3 = pack8(p1, 8);
        if (more) LSTOREK(kbuf ^ 1);
        LSTOREV(kbuf);
        __syncthreads();
    }
    if (BR == 2) {
#pragma unroll
        for (int x = 0; x < 8; ++x) z[x] = __builtin_nontemporal_load((const u32x4*)(zsrc + (size_t)x * (4 * 2048 * 2))); }
    if (Kn) { const char* p_ = (const char*)Kn + (size_t)c * 16384; fk0 = *(const u32x4*)(p_ + goff); fk1 = *(const u32x4*)(p_ + 8192 + goff); p_ = (const char*)Vn + (size_t)c * 16384; fv0 = *(const u32x4*)(p_ + goff); fv1 = *(const u32x4*)(p_ + 8192 + goff); }
    { const LAS unsigned char* vb = lds + L_V + ((ntiles - 1) & 1) * VBUF + vlane;
      pv_step(o, vb, pk0); pv_step(o, vb + 16 * VP, pk1); pv_step(o, vb + 32 * VP, pk2_); pv_step(o, vb + 48 * VP, pk3); }
    __syncthreads();
#undef GLOADX
#undef LSTOREK
#undef LSTOREV
#undef GLOADV
#undef QKT
#undef KRD
#undef KMM
#undef VRD
#undef VMM
#undef SB0
    if (lagw) __builtin_amdgcn_s_setprio(0);
    lsum = l + xhalf(l);
}

DI void attn_unit(LAS unsigned char* lds, unsigned char* ws, int bg, int c, int tid_in, int wave) {
    int tid = tid_in; asm volatile("" : "+v"(tid));
    const int lane = tid & 63;
    const int b = bg >> 2, g = bg & 3, h = lane >> 5, r32 = lane & 31, hh = wave >> 1, th = wave & 1, head = 4 * g + hh;
    const int tokoff = 32 * th + r32; const size_t trow = (size_t)b * 2048 + 64 * c + tokoff;
    bf16x8 q[8];
    { const bf16_t* qp = (const bf16_t*)(ws + pg8::WS_Q) + trow * 2048 + head * 128 + 8 * h;
#pragma unroll
      for (int ks = 0; ks < 8; ++ks) q[ks] = *(const bf16x8*)(qp + 16 * ks); }
    const bf16_t* gn = (const bf16_t*)(ws + pg8::WS_GN) + trow * 256 + head;
    const float g0 = bf2f(gn[0]), g1 = bf2f(gn[16]), g2 = bf2f(gn[32]);
#define PARKP(d, u) ((LAS u32x2*)(lds + L_PARK + wave * 8192 + ((d) * 4 + (u)) * 512 + lane * 8))
    const bf16_t* const KSg = (const bf16_t*)(ws + pg8::WS_KC + 2 * pg8::SZ_KV) + (size_t)bg * 2048 * 128; const bf16_t* const VSg = (const bf16_t*)(ws + pg8::WS_KC + 3 * pg8::SZ_KV) + (size_t)bg * 2048 * 128;
    const bf16_t* const KWg = (const bf16_t*)(ws + pg8::WS_KC + 4 * pg8::SZ_KV) + (size_t)bg * 2048 * 128; const bf16_t* const VWg = (const bf16_t*)(ws + pg8::WS_KC + 5 * pg8::SZ_KV) + (size_t)bg * 2048 * 128;
    u32x4 fk0, fk1, fv0, fv1;
    u32x4 z[8];
    const char* const ZAl = (const char*)(ws + pg8::WS_ZA) + (((size_t)b * 2048 + 64 * c + 32 * th) * 2048 + head * 128) * 2 + (unsigned)((lane >> 4) * 2048 + (lane & 15) * 8) * 2u;
    f32x16 o[4]; float g0s = 0.f;
#ifndef ATT_SKIP_CMP
    {
        const bf16_t* kc = (const bf16_t*)(ws + pg8::WS_KCB) + (size_t)bg * 128 * 128; const bf16_t* vc = (const bf16_t*)(ws + pg8::WS_VCB) + (size_t)bg * 128 * 128;
#pragma unroll
        for (int x = 0; x < 4; ++x) { const int ch = tid + 512 * x, key = ch >> 4, part = ch & 15;
            *(LAS u32x4*)(lds + L_K + key * KP + part * 16) = *(const u32x4*)(kc + key * 128 + part * 8);
            *(LAS u32x4*)(lds + L_V + key * VP + part * 16) = *(const u32x4*)(vc + key * 128 + part * 8); }
        __syncthreads();
        f32x16 s[4];
        const int ntc = (4 * c + 3 + 31) >> 5;
        const int tok = 64 * c + tokoff; const int nvis = (tok >= 31) ? ((tok - 31) >> 4) + 1 : 0;
#pragma unroll
        for (int t = 0; t < 4; ++t)
#pragma unroll
            for (int i = 0; i < 16; ++i) s[t][i] = NEG;
#pragma unroll
        for (int tp = 0; tp < 2; ++tp) if (2 * tp < ntc) {
            f32x16 a0, a1;
#pragma unroll
            for (int i = 0; i < 16; ++i) { a0[i] = 0.f; a1[i] = 0.f; }
            const LAS unsigned char* kb = lds + L_K + (64 * tp + r32) * KP + h * 16;
#pragma unroll
            for (int ks = 0; ks < 8; ++ks) { a0 = MFMA32(*(const LAS bf16x8*)(kb + ks * 32), q[ks], a0); a1 = MFMA32(*(const LAS bf16x8*)(kb + 32 * KP + ks * 32), q[ks], a1); if (ks & 1) __builtin_amdgcn_sched_barrier(0); }
            if (64 * tp + 64 > 4 * c - 1) {
#pragma unroll
                for (int i = 0; i < 16; ++i) { const int n = 64 * tp + crow(i, h); a0[i] = (n < nvis) ? a0[i] : NEG; a1[i] = (n + 32 < nvis) ? a1[i] : NEG; }
            }
            s[2 * tp] = a0; s[2 * tp + 1] = a1;
        }
        float m = NEG;
#pragma unroll
        for (int t = 0; t < 4; ++t)
#pragma unroll
            for (int i = 0; i < 16; ++i) m = fmaxf(m, s[t][i]);
        m = fmaxf(m, xhalf(m));
        float l = 0.f;
#pragma unroll
        for (int t = 0; t < 4; ++t)
#pragma unroll
            for (int i = 0; i < 16; ++i) { s[t][i] = ex2(s[t][i] - m); l += s[t][i]; }
        l += xhalf(l);
        const float inv = (nvis > 0) ? 1.0f / l : 0.f;
        LAS float* impH = (LAS float*)(lds + L_IMPH) + (hh * 64 + tokoff) * 33;
#pragma unroll
        for (int t = 0; t < 4; ++t)
#pragma unroll
            for (int u = 0; u < 4; ++u) {
                const float bown = 0.5f * s[t][4 * u + 3];
                float bprev = 0.f; if (u > 0) bprev = 0.5f * s[t][4 * u - 1]; else if (t > 0) bprev = 0.5f * s[t - 1][15];
                const float send = h ? bprev : bown;
                const float recv = xhalf(send);
                const float a = s[t][4 * u] + s[t][4 * u + 1] + s[t][4 * u + 2] + bown;
                impH[8 * t + 2 * u + h] = (a + recv) * inv;
            }
#pragma unroll
        for (int d = 0; d < 4; ++d)
#pragma unroll
            for (int i = 0; i < 16; ++i) o[d][i] = 0.f;
        const LAS unsigned char* vb = lds + L_V + (4 * h + ((lane & 15) >> 2)) * VP + ((lane >> 4) & 1) * 32 + (lane & 3) * 8;
#pragma unroll
        for (int t = 0; t < 4; ++t) if (t < ntc) { pv_step(o, vb + (32 * t) * VP, pack8(s[t], 0)); pv_step(o, vb + (32 * t + 16) * VP, pack8(s[t], 8)); }
        g0s = g0 * inv;
        { const char* p_ = (const char*)KSg + (size_t)c * 16384 + (unsigned)tid * 16u; fk0 = *(const u32x4*)p_; fk1 = *(const u32x4*)(p_ + 8192);
          p_ = (const char*)VSg + (size_t)c * 16384 + (unsigned)tid * 16u; fv0 = *(const u32x4*)p_; fv1 = *(const u32x4*)(p_ + 8192); }
        __syncthreads();
        { LAS float* IH = (LAS float*)(lds + L_IMPH); LAS unsigned* IM = (LAS unsigned*)(lds + L_IMP);
#pragma unroll
          for (int x = 0; x < 4; ++x) { const int e = tid + 512 * x, j = e & 31;
              const int ei = (e >> 5) * 33 + j;
              float v = ((IH[ei] + IH[64 * 33 + ei]) + IH[2 * 64 * 33 + ei]) + IH[3 * 64 * 33 + ei];
              const bool causal = j <= c, forced = (j == 0 || j == c || j == c - 1);
              v = forced ? 1e4f : v;
              IM[e] = causal ? ((__float_as_uint(v) & ~31u) | (unsigned)(31 - j)) : 0u; }
          __syncthreads();
          LAS unsigned* MK = (LAS unsigned*)(lds + L_MASK);
#pragma unroll
          for (int x = 0; x < 4; ++x) { const int e = tid + 512 * x, tk = e >> 5, j = e & 31; const unsigned v = IM[e]; int cnt = 0;
#pragma unroll
              for (int i4 = 0; i4 < 8; ++i4) { const u32x4 w = *(const LAS u32x4*)(IM + tk * 32 + 4 * i4);
                  cnt += (w.x > v) + (w.y > v) + (w.z > v) + (w.w > v); }
              const unsigned long long bal = __ballot(cnt < 8 && j <= c);
              if ((lane & 31) == 0) MK[tk] = (unsigned)(bal >> (lane & 32)); }
          __syncthreads(); }
    }
#endif
    const unsigned selmask = ((const LAS unsigned*)(lds + L_MASK))[tokoff];
#pragma unroll
    for (int d = 0; d < 4; ++d)
#pragma unroll
        for (int u = 0; u < 4; ++u) { u32x2 w; w.x = pk2(o[d][4 * u] * g0s, o[d][4 * u + 1] * g0s); w.y = pk2(o[d][4 * u + 2] * g0s, o[d][4 * u + 3] * g0s); *PARKP(d, u) = w; }
    float lsum = 1.f;
#ifndef ATT_SKIP_SEL
    flash<1>(lds, KSg, VSg, c, q, o, lsum, selmask, tokoff, lane, tid, fk0, fk1, fv0, fv1, KWg, VWg, (const char*)nullptr, z);
#endif
    { const float sc = g1 / lsum;
#pragma unroll
      for (int d = 0; d < 4; ++d)
#pragma unroll
          for (int u = 0; u < 4; ++u) { const u32x2 pw = *PARKP(d, u); u32x2 w;
              w.x = pk2(bflo(pw.x) + o[d][4 * u] * sc, bfhi(pw.x) + o[d][4 * u + 1] * sc); w.y = pk2(bflo(pw.y) + o[d][4 * u + 2] * sc, bfhi(pw.y) + o[d][4 * u + 3] * sc); *PARKP(d, u) = w; } }
#ifndef ATT_SKIP_WIN
    flash<2>(lds, KWg, VWg, c, q, o, lsum, 0u, tokoff, lane, tid, fk0, fk1, fv0, fv1, (const bf16_t*)nullptr, (const bf16_t*)nullptr, ZAl, z);
#endif
    { const float sc = g2 / lsum; LAS unsigned char* stg = lds + wave * (32 * 272);
      const size_t ub = (((size_t)b * 2048 + 64 * c + 32 * th) * 2048 + head * 128) * 2;
      const char* ZA = (const char*)(ws + pg8::WS_ZA) + ub; char* A1 = (char*)(ws + pg8::WS_A1) + ub;
      const unsigned lo_ = (unsigned)((lane >> 4) * 2048 + (lane & 15) * 8) * 2u;
#pragma unroll
      for (int d = 0; d < 4; ++d)
#pragma unroll
          for (int u = 0; u < 4; ++u) { const u32x2 pw = *PARKP(d, u); u32x2 w;
              w.x = pk2(bflo(pw.x) + o[d][4 * u] * sc, bfhi(pw.x) + o[d][4 * u + 1] * sc); w.y = pk2(bflo(pw.y) + o[d][4 * u + 2] * sc, bfhi(pw.y) + o[d][4 * u + 3] * sc);
              *(LAS u32x2*)(stg + r32 * 272 + (32 * d + 8 * u + 4 * h) * 2) = w; }
      LDS_WAIT();
#pragma unroll
      for (int x = 0; x < 8; ++x) { const int idx = x * 64 + lane, row = idx >> 4, pt = idx & 15; const u32x4 v = *(const LAS u32x4*)(stg + row * 272 + pt * 16);
          const size_t go = (size_t)x * (4 * 2048 * 2) + lo_;
          u32x4 w; w.x = pk2(bflo(v.x) * bflo(z[x].x), bfhi(v.x) * bfhi(z[x].x)); w.y = pk2(bflo(v.y) * bflo(z[x].y), bfhi(v.y) * bfhi(z[x].y));
          w.z = pk2(bflo(v.z) * bflo(z[x].z), bfhi(v.z) * bfhi(z[x].z)); w.w = pk2(bflo(v.w) * bflo(z[x].w), bfhi(v.w) * bfhi(z[x].w));
          *(u32x4*)(A1 + go) = w; }
    }
#undef PARKP
    __syncthreads();
}
}
#define XB_TMO      128
#define XB_XCNT(j)  (256  + 64 * (j))
#define XB_XSUB(j)  (1280 + 64 * (j))
#define XB_XGEN(j)  (2304 + 64 * (j))
#define XB_TOP      3328
#define XB_TOPGEN   3392
#define XCD_BAR_WORDS 3456
#define XB_SPIN_CAP (1u << 18)

__device__ __forceinline__ unsigned xb_ld(unsigned* p)              { return __hip_atomic_load(p, __ATOMIC_RELAXED, __HIP_MEMORY_SCOPE_AGENT); }
__device__ __forceinline__ unsigned xb_add(unsigned* p, unsigned v) { return __hip_atomic_fetch_add(p, v, __ATOMIC_RELAXED, __HIP_MEMORY_SCOPE_AGENT); }
__device__ __forceinline__ unsigned xb_xcc_id() { return (unsigned)__builtin_amdgcn_s_getreg((3 << 11) | 20) & 0xFu; }
#define XB_SPIN(cond, bar) do { unsigned _sp = 0; while (cond) { __builtin_amdgcn_s_sleep(1); \
    if ((++_sp & 255u) == 0u) { if (xb_ld(&(bar)[XB_TMO])) break; if (_sp > XB_SPIN_CAP) { atomicAdd(&(bar)[XB_TMO], 1u); break; } } } } while (0)

struct XcdBarrier {
    unsigned* bar; unsigned x;
    volatile LAS unsigned* st;
};

__device__ __forceinline__ XcdBarrier xcd_barrier_post(unsigned* bar, volatile LAS unsigned* st) {
    XcdBarrier b; b.bar = bar; b.x = xb_xcc_id(); b.st = st;
    if (threadIdx.x == 0) (void)xb_add(&bar[XB_XCNT(b.x)], 1u);
    return b;
}
__device__ __forceinline__ void xcd_barrier_complete(unsigned* bar, unsigned x, unsigned& nloc, unsigned& nx) {
    const unsigned G = gridDim.x * gridDim.y * gridDim.z;
    unsigned sum, cnt, mine, sp = 0u;
    for (;;) {
        sum = 0u; cnt = 0u; mine = 0u;
#pragma unroll
        for (unsigned j = 0; j < 16; ++j) { const unsigned c = xb_ld(&bar[XB_XCNT(j)]); sum += c; cnt += (c > 0u) ? 1u : 0u; mine = (j == x) ? c : mine; }
        if (sum == G) break;
        __builtin_amdgcn_s_sleep(1);
        if ((++sp & 255u) == 0u) { if (xb_ld(&bar[XB_TMO])) break; if (sp > XB_SPIN_CAP) { atomicAdd(&bar[XB_TMO], 1u); break; } }
    }
    nloc = mine > 0u ? mine : 1u; nx = cnt > 0u ? cnt : 1u;
}

__device__ __forceinline__ void xcd_barrier_protocol(const XcdBarrier& b) {
        unsigned* bar = b.bar;
        __builtin_amdgcn_s_waitcnt(0);
        unsigned nloc = b.st[0], nx = b.st[1];
        if (nloc == 0u) { xcd_barrier_complete(bar, b.x, nloc, nx); b.st[0] = nloc; b.st[1] = nx; }
        const unsigned old = xb_add(&bar[XB_XSUB(b.x)], 1u);
        const unsigned gen = old / nloc;
        if (old + 1u == (gen + 1u) * nloc) {
            __builtin_amdgcn_fence(__ATOMIC_RELEASE, "agent");
            asm volatile("s_waitcnt vmcnt(0)" ::: "memory");
            const unsigned og = xb_add(&bar[XB_TOP], 1u);
            const unsigned tg = og / nx;
            if (og + 1u == (tg + 1u) * nx) xb_add(&bar[XB_TOPGEN], 1u);
            else XB_SPIN(xb_ld(&bar[XB_TOPGEN]) == tg, bar);
            __builtin_amdgcn_fence(__ATOMIC_ACQUIRE, "agent");
            xb_add(&bar[XB_XGEN(b.x)], 1u);
            asm volatile("s_waitcnt vmcnt(0)" ::: "memory");
        } else {
            XB_SPIN(xb_ld(&bar[XB_XGEN(b.x)]) == gen, bar);
            __builtin_amdgcn_fence(__ATOMIC_ACQUIRE, "agent");
            asm volatile("s_waitcnt vmcnt(0)" ::: "memory");
        }
}
__device__ __forceinline__ void xcd_barrier(const XcdBarrier& b) {
    asm volatile("s_waitcnt vmcnt(0)" ::: "memory");
    __syncthreads();
    if (threadIdx.x == 0) xcd_barrier_protocol(b);
    __syncthreads();
}

#ifndef MK_N_LAUNCHES
#define MK_N_LAUNCHES 1
#endif
constexpr int N_PHASES = 8;
#ifndef GEMM_REP_MASK
#define GEMM_REP_MASK 0
#endif
template <int SHIFT> struct RepOrder : pg8::StaticOrder {
    __device__ bool next(int i, pg8::Unit& u) const { return pg8::StaticOrder::next(i >> SHIFT, u); }
};
struct RevOrder : pg8::StaticOrder {
    __device__ bool next(int i, pg8::Unit& u) const { if (!pg8::StaticOrder::next(i, u)) return false; u.pn = nN - 1 - u.pn; return true; }
};
#define GREP(k) (((GEMM_REP_MASK) >> (k)) & 1)
struct ChainOrder : pg8::StaticOrder {
    __device__ bool next(int i, pg8::Unit& u) const { if (!pg8::StaticOrder::next(i >> 1, u)) return false; if (i & 1) { u.pm += 32; u.pn += 8; } return true; }
};
struct TwiceOrder : pg8::StaticOrder {
    __device__ bool next(int i, pg8::Unit& u) const { const int cnt = (nwg - c + G - 1) / G; return i < cnt ? pg8::StaticOrder::next(i, u) : (i < 2 * cnt ? pg8::StaticOrder::next(i - cnt, u) : false); }
};
constexpr int LDS_BYTES = 147456;
static_assert(att::L_END <= 146944 && pg8::STAGE_BYTES <= 131072, "LDS map");

__global__ void __launch_bounds__(512, 2) nsa_hybrid_fwd(Args a) {
    extern __shared__ __attribute__((aligned(16))) unsigned char lds_raw[];
    LAS unsigned char* lds = (LAS unsigned char*)lds_raw;
    for (int u = threadIdx.x; u < 128; u += 512) ((LAS unsigned*)(lds + 146944))[u] = 0u;
    __syncthreads();
    XcdBarrier bar = xcd_barrier_post((unsigned*)(a.ws + pg8::WS_CTL), (volatile LAS unsigned*)(lds + 146944 + 32));
    const int tid = threadIdx.x, lane = tid & 63, wave = __builtin_amdgcn_readfirstlane(tid >> 6);
    const int G = gridDim.x, bx = blockIdx.x;
    const int vcu = (G % 8 == 0) ? (bx % 8) * (G / 8) + bx / 8 : bx;
    unsigned char* ws = a.ws;
    const int lo = a.ph_lo, hi = a.ph_hi;
#ifndef PHASE_MASK
#define PHASE_MASK 0x1ff
#endif
#define IN(k) (((PHASE_MASK >> (k)) & 1) && lo <= (k) && (k) < hi)
#ifndef REPEAT_MASK
#define REPEAT_MASK 0
#endif
#define REPS(k) _Pragma("clang loop unroll(disable)") for (int rep_ = 0; rep_ < ((((REPEAT_MASK) >> (k)) & 1) ? a.ph_rep : 1); ++rep_)
#define SEAM(k) do { if (IN(k) && IN((k) + 1)) xcd_barrier(bar); } while (0)

    if (IN(0)) REPS(0) p0_phase<0>(lds, a, vcu, G, tid, lane, wave);
    SEAM(0);
    if (IN(1)) REPS(1) {
        pg8::Gemm g{(const bf16_t*)(ws + pg8::WS_HN), (const bf16_t*)(ws + pg8::WS_WIN), TOK, NPAD, DM}; RevOrder S; S.init(TOK, NPAD, G, bx);
        pg8::EpiIn E{ws, (const float*)(ws + pg8::WS_BIAS)};
        pg8::gemm_phase<pg8::EpiIn, RevOrder, true, true>(lds, g, S, E);
        { const int nfull = (77 * 32) % G; if (nfull != 0 && bx >= nfull) p0_phase<1>(lds, a, bx - nfull, G - nfull, tid, lane, wave); else if (nfull == 0) p0_phase<1>(lds, a, bx, G, tid, lane, wave); }
    }
    SEAM(1);
    if (IN(2)) REPS(2) {
        const int jb = bx >> 4, which = (jb >> 2) & 1, sp = jb & 3; const bool gj = bx < 128;
        { pg8::Gemm g{(const bf16_t*)(ws + pg8::WS_KC + (size_t)which * pg8::SZ_KV) + sp * 512, (const bf16_t*)(ws + (which ? pg8::WS_W1V : pg8::WS_W1K)) + sp * 512, 2048, 512, 512, 2048, 2048};
          RepOrder<GREP(2)> S; S.init(2048, 512, G, gj ? (bx & 15) : 16);
          pg8::EpiPlain E{(bf16_t*)(ws + (which ? pg8::WS_PQV : pg8::WS_PQK)) + (size_t)sp * 2048 * 512, 512}; pg8::gemm_phase<pg8::EpiPlain, RepOrder<GREP(2)>, true, true>(lds, g, S, E); }
        { const int hb = tid >> 8;
          if (gj) conv_run(ws, a.in[10], a.in[11], 768 + 2 * bx + hb, tid);
          else {
#pragma unroll 1
              for (int r = 0; r < 3; ++r) conv_run(ws, a.in[10], a.in[11], 6 * (bx - 128) + 2 * r + hb, tid); } }
    }
    SEAM(2);
    if (IN(3)) REPS(3) p3_phase(lds, ws, a.in[6], a.in[9], bx, G, tid);
    SEAM(3);
    if (IN(4)) REPS(4) {
        for (int pidx = vcu; pidx < 256; pidx += G) { const int bg = pidx >> 4, s = pidx & 15;
#pragma unroll 1
            for (int u2 = 0; u2 < 2; ++u2) att::attn_unit(lds, ws, bg, u2 ? s : 31 - s, tid, wave); }
    }
    SEAM(4);
    if (IN(5)) {
        pg8::Gemm g{(const bf16_t*)(ws + pg8::WS_A1), (const bf16_t*)(ws + pg8::WS_PAT), TOK, DM, DM}; ChainOrder S; S.init(TOK, DM, G, bx);
        pg8::EpiYChain E{(bf16_t*)(ws + pg8::WS_Y), (const bf16_t*)(ws + pg8::WS_GM)};
        pg8::gemm_phase<pg8::EpiYChain, ChainOrder, true, true>(lds, g, S, E);
    }
    f32x4 xacc[2][2][4][2];
    { pg8::StaticOrder S7; S7.init(TOK, DM, G, bx); pg8::Unit u7; u7.pm = 0; u7.pn = 0; (void)S7.next(0, u7);
      const float* xl = a.in[0] + (size_t)(u7.pm * 256 + (wave >> 2) * 64 + (lane & 15)) * 2048 + u7.pn * 256 + (wave & 3) * 32 + 8 * (lane >> 4);
#define LDX() do { _Pragma("unroll") for (int ai = 0; ai < 2; ++ai) _Pragma("unroll") for (int bj = 0; bj < 2; ++bj) _Pragma("unroll") for (int m = 0; m < 4; ++m) _Pragma("unroll") for (int n = 0; n < 2; ++n) \
          xacc[ai][bj][m][n] = __builtin_nontemporal_load((const f32x4*)(xl + (size_t)(ai * 128 + m * 16) * 2048 + bj * 128 + 4 * n)); } while (0)
      if (IN(6) && IN(7)) {
          asm volatile("s_waitcnt vmcnt(0)" ::: "memory"); __syncthreads();
          if (threadIdx.x != 0) LDX();
          if (threadIdx.x == 0) { xcd_barrier_protocol(bar); LDX(); }
          __syncthreads(); }
      else if (IN(7)) LDX();
#undef LDX
    }
    if (IN(7)) {
        pg8::Gemm g{(const bf16_t*)(ws + pg8::WS_Y), (const bf16_t*)(ws + pg8::WS_WOT), TOK, DM, DM}; pg8::StaticOrder S; S.init(TOK, DM, G, bx);
        pg8::EpiOutNorm E{a.in[0], a.out, a.in[15], (float*)(ws + pg8::WS_SLOTS), (unsigned*)(ws + pg8::WS_CTL) + pg8::CW_PANEL};
        pg8::gemm_phase<pg8::EpiOutNorm, pg8::StaticOrder, false, true>(lds, g, S, E, xacc);
    }
#undef IN
#undef SEAM
}

extern "C" void kernel_launch(void* const* d_in, const int* in_sizes, int n_in, void* d_out, int out_size, void* d_ws, size_t ws_size, hipStream_t stream) {
    static int grid = 0;
    if (grid == 0) {
        if (n_in != 16 || out_size != TOK * DM || ws_size < pg8::WS_END) { fprintf(stderr, "kernel_launch: unexpected shapes (n_in %d, out %d, ws %zu < %zu)\n", n_in, out_size, ws_size, (size_t)pg8::WS_END); grid = -1; return; }
        int dev = 0, cus = 0, per_cu = 0;
        (void)hipGetDevice(&dev); (void)hipDeviceGetAttribute(&cus, hipDeviceAttributeMultiprocessorCount, dev);
        (void)hipFuncSetAttribute((const void*)nsa_hybrid_fwd, hipFuncAttributeMaxDynamicSharedMemorySize, LDS_BYTES);
        (void)hipOccupancyMaxActiveBlocksPerMultiprocessor(&per_cu, (const void*)nsa_hybrid_fwd, 512, LDS_BYTES);
        if (per_cu < 1) { fprintf(stderr, "kernel_launch: occupancy query says %d blocks/CU\n", per_cu); per_cu = 1; }
        grid = cus * per_cu; if (grid > 256) grid = 256;
        if (grid != 256) { fprintf(stderr, "kernel_launch: this kernel needs 256 resident workgroups (got %d)\n", grid); grid = -1; return; }
    }
    if (grid < 0) return;
    (void)hipMemsetAsync((char*)d_ws + pg8::WS_CTL, 0, 65536, stream);
    Args a{};
    for (int i = 0; i < 16; ++i) a.in[i] = (const float*)d_in[i];
    a.out = (float*)d_out; a.ws = (unsigned char*)d_ws; a.ph_rep = 2;
#if MK_N_LAUNCHES == 1
    a.ph_lo = 0; a.ph_hi = N_PHASES;
    { void* args[] = {&a}; hipError_t e = hipLaunchCooperativeKernel((const void*)nsa_hybrid_fwd, dim3(grid), dim3(512), args, LDS_BYTES, stream);
      if (e != hipSuccess) fprintf(stderr, "cooperative launch failed: %s (grid %d)\n", hipGetErrorString(e), grid); }
#else
    for (int p = 0; p < N_PHASES; ++p) { a.ph_lo = p; a.ph_hi = p + 1;
        hipLaunchKernelGGL(nsa_hybrid_fwd, dim3(grid), dim3(512), LDS_BYTES, stream, a); }
#endif
}
```

```cpp
#include <hip/hip_runtime.h>
#include <hip/hip_cooperative_groups.h>
#include <cstdio>
#include <cstdint>
namespace cg = cooperative_groups;
namespace pg8 {
#define PG8_LAS __attribute__((address_space(3)))
typedef unsigned short bf16_t;
typedef short bf16x8 __attribute__((ext_vector_type(8)));
typedef float f32x4 __attribute__((ext_vector_type(4)));
typedef unsigned u32x4 __attribute__((ext_vector_type(4)));
constexpr int BM = 256, BK = 64, HALF = 128, HTB = HALF * BK * 2  , STAGE_BYTES = 8 * HTB, NXCD = 8, WGM = 8;

__host__ __device__ __forceinline__ int lds_byte(int r, int c) { const int st = (r >> 4) * 2 + (c >> 5), rr = r & 15, cc = c & 31, ob = rr * 64 + cc * 2; return st * 1024 + (ob ^ (((ob >> 9) & 1) << 5)); }
__host__ __device__ __forceinline__ void stage_rc(int b, int& R, int& C) { const int st = b / 1024, sb = b % 1024, swz = sb ^ (((sb >> 9) & 1) << 5); R = (st >> 1) * 16 + swz / 64; C = (st & 1) * 32 + (swz % 64) / 2; }
__host__ __device__ __forceinline__ int perm32(int rho) { const int n = rho >> 4, i = rho & 15; return 8 * (i >> 2) + 4 * n + (i & 3); }

struct Unit { int pm, pn; };
struct Gemm { const bf16_t* A; const bf16_t* Bt; int M, N, K; int lda = 0, ldb = 0; };

struct StaticOrder {
    int nM, nN, nwg, G, c;
    __host__ __device__ void init(int M, int N, int G_, int c_) { nM = M / BM; nN = N / BM; nwg = nM * nN; G = G_; c = c_; }
    __host__ __device__ bool next(int i, Unit& u) const {
        const long L = (long)i * G + c; if (L >= nwg) return false;
        int wgid = (int)L; { const int q = nwg / NXCD, r = nwg % NXCD, xcd = wgid % NXCD, off = wgid / NXCD; wgid = (xcd < r ? xcd * (q + 1) : r * (q + 1) + (xcd - r) * q) + off; }
        const int nig = WGM * nN, gid = wgid / nig, fm = gid * WGM, gsz = (nM - fm) < WGM ? (nM - fm) : WGM;
        u.pm = fm + ((wgid % nig) % gsz); u.pn = (wgid % nig) / gsz; return true;
    }
    __device__ __forceinline__ void a_ready(const Unit&) const {}
    __device__ __forceinline__ void done(const Unit&) const {}
};

__device__ __forceinline__ unsigned cvt_pk_bf16(float lo, float hi) { unsigned r; asm volatile("v_cvt_pk_bf16_f32 %0, %1, %2" : "=v"(r) : "v"(lo), "v"(hi)); return r; }
typedef float f32x2 __attribute__((ext_vector_type(2)));
typedef float f32x2_t __attribute__((ext_vector_type(2))); typedef __bf16 bf16x2_t __attribute__((ext_vector_type(2)));
__device__ __forceinline__ unsigned pk2(float lo, float hi) { f32x2_t v = {lo, hi}; bf16x2_t b = __builtin_convertvector(v, bf16x2_t); return __builtin_bit_cast(unsigned, b); }
__device__ __forceinline__ float bflo(unsigned w) { return __uint_as_float(w << 16); }
__device__ __forceinline__ float bfhi(unsigned w) { return __uint_as_float(w & 0xffff0000u); }
__device__ __forceinline__ float sigm_f(float v) { return __builtin_amdgcn_rcpf(1.f + __builtin_amdgcn_exp2f(-1.4426950408889634f * v)); }
__device__ __forceinline__ float silu_f(float v) { return v * sigm_f(v); }
constexpr int TOK = 8192, DM = 2048, NPAD = 19712;
constexpr float QSCALE = 0.08838834764831845f * 1.4426950408889634f;
constexpr size_t al256(size_t x) { return (x + 255) & ~(size_t)255; }
constexpr size_t SZ_TD = (size_t)TOK * DM * 2, SZ_KV = (size_t)TOK * 512 * 2, SZ_W = (size_t)DM * DM * 2;
constexpr size_t WS_CTL = 0;
constexpr size_t WS_WIN = 65536;
constexpr size_t WS_A1 = WS_WIN, WS_A2 = WS_WIN + SZ_TD;
constexpr size_t WS_HN = al256(WS_WIN + (size_t)NPAD * DM * 2);
constexpr size_t WS_Y = WS_HN;
constexpr size_t WS_PAT = WS_HN + SZ_TD, WS_PCT = WS_PAT + SZ_W, WS_WOT = WS_PCT + SZ_W;
constexpr size_t WS_W1K = WS_WOT + SZ_W, WS_W1V = WS_W1K + (size_t)512 * DM * 2;
constexpr size_t WS_BIAS = WS_W1V + (size_t)512 * DM * 2;
constexpr size_t WS_CPART = al256(WS_BIAS + (size_t)NPAD * 4);
constexpr size_t WS_Q = WS_CPART + 2 * 32 * 256 * 4;
constexpr size_t WS_KC = WS_Q + SZ_TD;
constexpr size_t WS_ZA = WS_KC + 6 * SZ_KV;
constexpr size_t WS_GM = WS_ZA + 5 * SZ_TD;
constexpr size_t WS_GN = WS_GM + 2 * SZ_TD;
constexpr size_t WS_PQK = WS_GN + (size_t)TOK * 256 * 2, WS_PQV = WS_PQK + (size_t)4 * 2048 * 512 * 2;
constexpr size_t WS_KCB = WS_PQV + (size_t)4 * 2048 * 512 * 2, WS_VCB = WS_KCB + 16 * 128 * 128 * 2;
constexpr size_t WS_PARK = WS_VCB + 16 * 128 * 128 * 2;
constexpr size_t WS_SLOTS = WS_PARK + (size_t)256 * 8 * 16384;
constexpr size_t WS_END = WS_SLOTS + (size_t)TOK * 32 * 4;
constexpr int CW_PANEL = 8192;

struct EpiIn {
    static constexpr bool PERM = true, AFTER_DRAIN = false;
    unsigned char* ws; const float* bias;
    __device__ __forceinline__ void load_bias(const Unit& u, int wc, int fq, f32x4 (&bv)[2][2]) const {
        const float* bp = bias + u.pn * BM + wc * 32 + 8 * fq;
#pragma unroll
        for (int bj = 0; bj < 2; ++bj)
#pragma unroll
            for (int n = 0; n < 2; ++n) bv[bj][n] = *(const f32x4*)(bp + bj * HALF + 4 * n);
    }
    __device__ __forceinline__ void operator()(const f32x4 (&acc)[2][2][4][2], const Unit& u, int wr, int wc, int fr, int fq) const {
        const int pn = u.pn;
        size_t off; int ldc, colt, act = 0; float sc = 1.f; bool kcl = false;
        if (pn < 8) { off = WS_Q; ldc = 2048; colt = pn * 256; sc = QSCALE; }
        else if (pn < 20) { const int s = (pn - 8) >> 1; off = WS_KC + (size_t)s * SZ_KV; ldc = 512; colt = ((pn - 8) & 1) * 256; kcl = true; }
        else if (pn < 60) { const int s = (pn - 20) >> 3; off = WS_ZA + (size_t)s * SZ_TD; ldc = 2048; colt = ((pn - 20) & 7) * 256; act = (s == 0 || s == 4) ? 1 : 0; }
        else if (pn < 76) { off = WS_GM; ldc = 4096; colt = (pn - 60) * 256; act = 2; }
        else { off = WS_GN; ldc = 256; colt = 0; act = 2; }
        bf16_t* base = (bf16_t*)(ws + off);
        const int row0 = u.pm * BM + wr * 64 + fr, cl = wc * 32 + 8 * fq, bcol0 = pn * BM + cl;
        if (pn >= 28 && pn < 60) {
            const bool bz = pn >= 44; bf16_t* ob = (bf16_t*)(ws + WS_ZA + (bz ? 2 : 1) * SZ_TD) + 128 * ((pn - 28) & 15) + cl;
#pragma unroll
            for (int ai = 0; ai < 2; ++ai)
#pragma unroll
                for (int m = 0; m < 4; ++m) { const int row = row0 + ai * HALF + m * 16;
                    f32x4 a0 = acc[ai][0][m][0], a1 = acc[ai][0][m][1], c0v = acc[ai][1][m][0], c1v = acc[ai][1][m][1];
                    if (bz) { c0v = (f32x4){silu_f(c0v[0]), silu_f(c0v[1]), silu_f(c0v[2]), silu_f(c0v[3])}; c1v = (f32x4){silu_f(c1v[0]), silu_f(c1v[1]), silu_f(c1v[2]), silu_f(c1v[3])}; }
                    a0 = a0 * c0v; a1 = a1 * c1v;
                    u32x4 w; w.x = pk2(a0[0], a0[1]); w.y = pk2(a0[2], a0[3]); w.z = pk2(a1[0], a1[1]); w.w = pk2(a1[2], a1[3]);
                    *(u32x4*)(ob + (size_t)row * 2048) = w; }
            return;
        }
        if (pn >= 60 && pn < 76) {
            bf16_t* ob = (bf16_t*)(ws + WS_GM) + 128 * (pn - 60) + cl;
#pragma unroll
            for (int ai = 0; ai < 2; ++ai)
#pragma unroll
                for (int m = 0; m < 4; ++m) { const int row = row0 + ai * HALF + m * 16;
                    const f32x4 a0 = acc[ai][0][m][0], a1 = acc[ai][0][m][1], c0v = acc[ai][1][m][0], c1v = acc[ai][1][m][1];
                    float r[8], g[8];
#pragma unroll
                    for (int k = 0; k < 4; ++k) { g[k] = fmaxf(sigm_f(c0v[k]), 1e-30f); g[4 + k] = fmaxf(sigm_f(c1v[k]), 1e-30f); r[k] = sigm_f(a0[k]) * __builtin_amdgcn_rcpf(g[k]); r[4 + k] = sigm_f(a1[k]) * __builtin_amdgcn_rcpf(g[4 + k]); }
                    u32x4 w; w.x = pk2(r[0], r[1]); w.y = pk2(r[2], r[3]); w.z = pk2(r[4], r[5]); w.w = pk2(r[6], r[7]);
                    *(u32x4*)(ob + (size_t)row * 2048) = w;
                    w.x = pk2(g[0], g[1]); w.y = pk2(g[2], g[3]); w.z = pk2(g[4], g[5]); w.w = pk2(g[6], g[7]);
                    *(u32x4*)(ob + (size_t)TOK * 2048 + (size_t)row * 2048) = w; }
            return;
        }
#pragma unroll
        for (int ai = 0; ai < 2; ++ai)
#pragma unroll
            for (int m = 0; m < 4; ++m) { const int row = row0 + ai * HALF + m * 16;
#pragma unroll
                for (int bj = 0; bj < 2; ++bj) { f32x4 v0 = acc[ai][bj][m][0], v1 = acc[ai][bj][m][1];
                    if (act == 1) { v0 = (f32x4){silu_f(v0[0]), silu_f(v0[1]), silu_f(v0[2]), silu_f(v0[3])}; v1 = (f32x4){silu_f(v1[0]), silu_f(v1[1]), silu_f(v1[2]), silu_f(v1[3])}; }
                    else if (act == 2) { v0 = (f32x4){sigm_f(v0[0]), sigm_f(v0[1]), sigm_f(v0[2]), sigm_f(v0[3])}; v1 = (f32x4){sigm_f(v1[0]), sigm_f(v1[1]), sigm_f(v1[2]), sigm_f(v1[3])}; }
                    v0 = v0 * sc; v1 = v1 * sc;
                    u32x4 w; w.x = pk2(v0[0], v0[1]); w.y = pk2(v0[2], v0[3]); w.z = pk2(v1[0], v1[1]); w.w = pk2(v1[2], v1[3]);
                    const int c = colt + cl + bj * HALF;
                    bf16_t* dst;
                    if (kcl) { const int b = row >> 11, s = row & 2047, g = c >> 7, d = c & 127; dst = base + ((size_t)((b * 4 + g) * 2048 + s)) * 128 + d; }
                    else dst = base + (size_t)row * ldc + c;
                    *(u32x4*)dst = w; } }
    }
};
struct EpiPlain {
    static constexpr bool PERM = true, AFTER_DRAIN = false;
    bf16_t* O; int ldc;
    __device__ __forceinline__ void operator()(const f32x4 (&acc)[2][2][4][2], const Unit& u, int wr, int wc, int fr, int fq) const {
        const int row0 = u.pm * BM + wr * 64 + fr, c0 = u.pn * BM + wc * 32 + 8 * fq;
#pragma unroll
        for (int ai = 0; ai < 2; ++ai)
#pragma unroll
            for (int m = 0; m < 4; ++m)
#pragma unroll
                for (int bj = 0; bj < 2; ++bj) { const f32x4 v0 = acc[ai][bj][m][0], v1 = acc[ai][bj][m][1];
                    u32x4 w; w.x = pk2(v0[0], v0[1]); w.y = pk2(v0[2], v0[3]); w.z = pk2(v1[0], v1[1]); w.w = pk2(v1[2], v1[3]);
                    *(u32x4*)(O + (size_t)(row0 + ai * HALF + m * 16) * ldc + c0 + bj * HALF) = w; }
    }
};
template <int MODE> struct EpiY {
    static constexpr bool PERM = true, AFTER_DRAIN = false;
    bf16_t* Y; const bf16_t* GM;
    __device__ __forceinline__ void operator()(const f32x4 (&acc)[2][2][4][2], const Unit& u, int wr, int wc, int fr, int fq) const {
        const int row0 = u.pm * BM + wr * 64 + fr, c0 = u.pn * BM + wc * 32 + 8 * fq;
#pragma unroll
        for (int ai = 0; ai < 2; ++ai)
#pragma unroll
            for (int m = 0; m < 4; ++m)
#pragma unroll
                for (int bj = 0; bj < 2; ++bj) { const size_t row = (size_t)(row0 + ai * HALF + m * 16); const int c = c0 + bj * HALF;
                    const u32x4 g = *(const u32x4*)(GM + row * 4096 + MODE * 2048 + c);
                    f32x4 v0 = acc[ai][bj][m][0], v1 = acc[ai][bj][m][1];
                    v0 = v0 * (f32x4){bflo(g.x), bfhi(g.x), bflo(g.y), bfhi(g.y)}; v1 = v1 * (f32x4){bflo(g.z), bfhi(g.z), bflo(g.w), bfhi(g.w)};
                    u32x4* yp = (u32x4*)(Y + row * 2048 + c);
                    if (MODE == 1) { const u32x4 y = *yp; v0 = v0 + (f32x4){bflo(y.x), bfhi(y.x), bflo(y.y), bfhi(y.y)}; v1 = v1 + (f32x4){bflo(y.z), bfhi(y.z), bflo(y.w), bfhi(y.w)}; }
                    u32x4 w; w.x = pk2(v0[0], v0[1]); w.y = pk2(v0[2], v0[3]); w.z = pk2(v1[0], v1[1]); w.w = pk2(v1[2], v1[3]);
                    *yp = w; }
    }
};
struct EpiYChain {
    static constexpr bool PERM = true, AFTER_DRAIN = false;
    bf16_t* Y; const bf16_t* GM;
    __device__ __forceinline__ bool keep_acc(const Unit& u) const { return u.pm < 32; }
    __device__ __forceinline__ void operator()(f32x4 (&acc)[2][2][4][2], const Unit& u, int wr, int wc, int fr, int fq) const {
        const bool first = u.pm < 32;
        const int row0 = (u.pm & 31) * BM + wr * 64 + fr, c0 = (u.pn & 7) * BM + wc * 32 + 8 * fq;
#pragma unroll
        for (int ai = 0; ai < 2; ++ai) {
            u32x4 gv[4][2];
            const bf16_t* G = GM + (first ? (size_t)0 : (size_t)TOK * 2048);
#pragma unroll
            for (int m = 0; m < 4; ++m)
#pragma unroll
                for (int bj = 0; bj < 2; ++bj) gv[m][bj] = __builtin_nontemporal_load((const u32x4*)(G + (size_t)(row0 + ai * HALF + m * 16) * 2048 + c0 + bj * HALF));
#pragma unroll
            for (int m = 0; m < 4; ++m)
#pragma unroll
                for (int bj = 0; bj < 2; ++bj) { const size_t row = (size_t)(row0 + ai * HALF + m * 16); const int c = c0 + bj * HALF;
                    const u32x4 g1 = gv[m][bj];
                    const f32x4 s0 = {bflo(g1.x), bfhi(g1.x), bflo(g1.y), bfhi(g1.y)}, s1 = {bflo(g1.z), bfhi(g1.z), bflo(g1.w), bfhi(g1.w)};
                    if (first) { acc[ai][bj][m][0] = acc[ai][bj][m][0] * s0; acc[ai][bj][m][1] = acc[ai][bj][m][1] * s1; }
                    else { const f32x4 v0 = acc[ai][bj][m][0] * s0, v1 = acc[ai][bj][m][1] * s1;
                        u32x4 w; w.x = pk2(v0[0], v0[1]); w.y = pk2(v0[2], v0[3]); w.z = pk2(v1[0], v1[1]); w.w = pk2(v1[2], v1[3]);
                        *(u32x4*)(Y + row * 2048 + c) = w; } }
            asm volatile("" ::: "memory");
        }
    }
};
struct EpiOutNorm {
    static constexpr bool PERM = true, AFTER_DRAIN = true;
    const float* x; float* out; const float* fg; float* slots; unsigned* cnt;
    __device__ __forceinline__ void fused(f32x4 (&acc)[2][2][4][2], const Unit& u, int wr, int wc, int fr, int fq, PG8_LAS unsigned char* lds, int wid, int lane) const {
        const int row0 = u.pm * BM + wr * 64 + fr, c0 = u.pn * BM + wc * 32 + 8 * fq;
        f32x4 gv[2][2];
#pragma unroll
        for (int bj = 0; bj < 2; ++bj) { gv[bj][0] = *(const f32x4*)(fg + c0 + bj * HALF); gv[bj][1] = *(const f32x4*)(fg + c0 + bj * HALF + 4); }
#pragma unroll
        for (int ai = 0; ai < 2; ++ai)
#pragma unroll
            for (int m = 0; m < 4; ++m) { float s = 0.f;
#pragma unroll
                for (int bj = 0; bj < 2; ++bj) { const f32x4 a = acc[ai][bj][m][0], b = acc[ai][bj][m][1];
                    s += (a[0] * a[0] + a[1] * a[1]) + (a[2] * a[2] + a[3] * a[3]) + (b[0] * b[0] + b[1] * b[1]) + (b[2] * b[2] + b[3] * b[3]); }
                s += __shfl_xor(s, 16); s += __shfl_xor(s, 32);
                if (fq == 0) __hip_atomic_store(slots + (size_t)(row0 + ai * HALF + m * 16) * 32 + u.pn * 4 + wc, s, __ATOMIC_RELAXED, __HIP_MEMORY_SCOPE_AGENT); }
        asm volatile("s_waitcnt vmcnt(0)" ::: "memory");
        if (lane == 0) __hip_atomic_fetch_add(cnt + 64 * u.pm, 1u, __ATOMIC_RELAXED, __HIP_MEMORY_SCOPE_AGENT);
        if (wid == 0) {
            unsigned sp = 0;
            while ((unsigned)__builtin_amdgcn_readfirstlane(__hip_atomic_load(cnt + 64 * u.pm, __ATOMIC_RELAXED, __HIP_MEMORY_SCOPE_AGENT)) < 64u) { __builtin_amdgcn_s_sleep(2); if (++sp > (1u << 22)) break; }
            __builtin_amdgcn_fence(__ATOMIC_ACQUIRE, "agent");
        }
        asm volatile("s_waitcnt vmcnt(0) lgkmcnt(0)" ::: "memory"); __builtin_amdgcn_s_barrier(); asm volatile("" ::: "memory");
        PG8_LAS float* R = (PG8_LAS float*)lds;
        { const int t = wid * 64 + lane, r = t >> 1, hf = t & 1; const float* sl = slots + (size_t)(u.pm * BM + r) * 32 + hf * 16; float s = 0.f;
#pragma unroll
          for (int k = 0; k < 16; ++k) s += __hip_atomic_load(sl + k, __ATOMIC_RELAXED, __HIP_MEMORY_SCOPE_AGENT);
          s += __shfl_xor(s, 1);
          if (hf == 0) R[r] = 1.0f / sqrtf(s * (1.0f / 2048.0f) + 1e-6f); }
        asm volatile("s_waitcnt lgkmcnt(0)" ::: "memory"); __builtin_amdgcn_s_barrier(); asm volatile("" ::: "memory");
#pragma unroll
        for (int ai = 0; ai < 2; ++ai)
#pragma unroll
            for (int m = 0; m < 4; ++m) { const int rl = ai * HALF + wr * 64 + m * 16 + fr; const float rs = R[rl];
#pragma unroll
                for (int bj = 0; bj < 2; ++bj) { const size_t o = (size_t)(u.pm * BM + rl) * 2048 + c0 + bj * HALF;
                    *(f32x4*)(out + o) = acc[ai][bj][m][0] * rs * gv[bj][0]; *(f32x4*)(out + o + 4) = acc[ai][bj][m][1] * rs * gv[bj][1]; } }
    }
};
template <class E> constexpr bool epi_has_bias = false;
template <> constexpr bool epi_has_bias<EpiIn> = true;
template <class E> __device__ __forceinline__ auto keep_acc_of(const E& e, const Unit& u, int) -> decltype(e.keep_acc(u)) { return e.keep_acc(u); }
template <class E> __device__ __forceinline__ bool keep_acc_of(const E&, const Unit&, long) { return false; }
template <class Epi, class Sched, bool ALIGN_EPI = false, bool SP2 = false>
__device__ __forceinline__ void gemm_phase(PG8_LAS unsigned char* lds, const Gemm g, const Sched& S, const Epi& E, const f32x4 (*acc0)[2][4][2] = nullptr) {
    const int tid = threadIdx.x, wid = __builtin_amdgcn_readfirstlane(tid >> 6), lane = tid & 63, wr = wid >> 2, wc = wid & 3, fr = lane & 15, fq = lane >> 4;
    const int K = g.K, nt = K / BK; const int lda = g.lda ? g.lda : K, ldb = g.ldb ? g.ldb : K;
    unsigned voffA[2], voffB[2];
#pragma unroll
    for (int i = 0; i < 2; ++i) { int R, C; stage_rc(tid * 16 + i * 8192, R, C); const int Rb = Epi::PERM ? ((R & ~31) + perm32(R & 31)) : R;
        voffA[i] = (unsigned)(R * lda + C) * 2u; voffB[i] = (unsigned)(Rb * ldb + C) * 2u; }
    const size_t kstep = (size_t)(BK * 2);
    const size_t hstepA = (size_t)HALF * lda * 2, hstepB = (size_t)HALF * ldb * 2;
    const size_t tstepA = 2 * hstepA, tstepB = 2 * hstepB;
    const unsigned ldsw = (unsigned)wid * 1024u;
    const int aoff = lds_byte(wr * 64 + fr, fq * 8), boff = lds_byte(wc * 32 + fr, fq * 8);
#define PG8_SA(b, h) (((b) * 2 + (h)) * HTB)
#define PG8_SB(b, h) ((4 + (b) * 2 + (h)) * HTB)
#define PG8_STAGE(bufoff, gbase, voff) do { _Pragma("unroll") for (int _i = 0; _i < 2; ++_i) \
        __builtin_amdgcn_global_load_lds((const unsigned*)((const char*)(gbase) + (voff)[_i]), (PG8_LAS unsigned*)(lds + (bufoff) + ldsw + _i * 8192), 16, 0, 0); } while (0)
#define PG8_LDA(dst, b, h) do { _Pragma("unroll") for (int m = 0; m < 4; ++m) _Pragma("unroll") for (int k = 0; k < 2; ++k) dst[m][k] = *(const PG8_LAS bf16x8*)(lds + PG8_SA(b, h) + aoff + m * 2048 + k * 1024); } while (0)
#define PG8_LDB(dst, b, h) do { _Pragma("unroll") for (int n = 0; n < 2; ++n) _Pragma("unroll") for (int k = 0; k < 2; ++k) dst[n][k] = *(const PG8_LAS bf16x8*)(lds + PG8_SB(b, h) + boff + n * 2048 + k * 1024); } while (0)
#define PG8_MMA(ai, bj, At, Bt) do { __builtin_amdgcn_s_setprio(1); _Pragma("unroll") for (int m = 0; m < 4; ++m) _Pragma("unroll") for (int n = 0; n < 2; ++n) _Pragma("unroll") for (int k = 0; k < 2; ++k) \
        acc[ai][bj][m][n] = __builtin_amdgcn_mfma_f32_16x16x32_bf16(Bt[n][k], At[m][k], acc[ai][bj][m][n], 0, 0, 0); __builtin_amdgcn_s_setprio(0); } while (0)
#define PG8_WAIT_V(n) asm volatile("s_waitcnt vmcnt(" #n ")" ::: "memory")
#define PG8_WAIT_L(n) asm volatile("s_waitcnt lgkmcnt(" #n ")" ::: "memory")
#define PG8_BAR __builtin_amdgcn_s_barrier()
#define PG8_SCHED __builtin_amdgcn_sched_barrier(0)
    Unit cur, nxt; int ui = 0;
    if (!S.next(0, cur)) return;
    f32x4 acc[2][2][4][2];
#pragma unroll
    for (int a = 0; a < 2; ++a)
#pragma unroll
        for (int b = 0; b < 2; ++b)
#pragma unroll
            for (int m = 0; m < 4; ++m)
#pragma unroll
                for (int n = 0; n < 2; ++n) acc[a][b][m][n] = acc0 ? acc0[a][b][m][n] : (f32x4){0.f, 0.f, 0.f, 0.f};
    f32x4 bnx[2][2];
    if constexpr (epi_has_bias<Epi>) { E.load_bias(cur, wc, fq, bnx);
#pragma unroll
        for (int a = 0; a < 2; ++a)
#pragma unroll
            for (int b = 0; b < 2; ++b)
#pragma unroll
                for (int m = 0; m < 4; ++m)
#pragma unroll
                    for (int n = 0; n < 2; ++n) acc[a][b][m][n] = bnx[b][n]; }
    bf16x8 At[4][2], B0[2][2], B1[2][2];
    const char* cA = (const char*)g.A + (size_t)cur.pm * tstepA; const char* cB = (const char*)g.Bt + (size_t)cur.pn * tstepB;
    S.a_ready(cur);
    if constexpr (SP2) {
        PG8_STAGE(PG8_SB(0, 0), cB, voffB); PG8_STAGE(PG8_SB(0, 1), cB + hstepB, voffB); PG8_STAGE(PG8_SA(0, 0), cA, voffA); PG8_STAGE(PG8_SA(0, 1), cA + hstepA, voffA);
        if (wr == 1) PG8_BAR;
        PG8_WAIT_V(2); PG8_BAR;
        PG8_STAGE(PG8_SB(1, 0), cB + kstep, voffB); PG8_STAGE(PG8_SA(1, 0), cA + kstep, voffA); PG8_STAGE(PG8_SB(1, 1), cB + hstepB + kstep, voffB);
        PG8_WAIT_V(6); PG8_BAR;
    } else {
        PG8_STAGE(PG8_SB(0, 0), cB, voffB); PG8_STAGE(PG8_SA(0, 0), cA, voffA); PG8_STAGE(PG8_SB(0, 1), cB + hstepB, voffB); PG8_STAGE(PG8_SA(0, 1), cA + hstepA, voffA);
        if (wr == 1) PG8_BAR;
        PG8_WAIT_V(4); PG8_BAR;
        PG8_STAGE(PG8_SB(1, 0), cB + kstep, voffB); PG8_STAGE(PG8_SA(1, 0), cA + kstep, voffA); PG8_STAGE(PG8_SB(1, 1), cB + hstepB + kstep, voffB);
        PG8_WAIT_V(6); PG8_BAR;
    }
    for (;;) {
        const bool has_next = S.next(ui + 1, nxt);
        const char* nA = has_next ? (const char*)g.A + (size_t)nxt.pm * tstepA : cA; const char* nB = has_next ? (const char*)g.Bt + (size_t)nxt.pn * tstepB : cB;
        for (int t = 0; t < nt; t += 2) {
            const bool last = (t == nt - 2);
            const char* a1 = cA + (size_t)(t + 1) * kstep;
            const char* a2 = last ? nA : cA + (size_t)(t + 2) * kstep; const char* b2 = last ? nB : cB + (size_t)(t + 2) * kstep;
            const char* a3 = a2 + kstep; const char* b3 = b2 + kstep;
            if (last && has_next) S.a_ready(nxt);
            if constexpr (SP2) {
            PG8_LDB(B0, 0, 0); PG8_LDB(B1, 0, 1); PG8_SCHED; PG8_LDA(At, 0, 0); PG8_STAGE(PG8_SA(1, 1), a1 + hstepA, voffA);
            PG8_WAIT_V(8); PG8_WAIT_L(0); PG8_BAR; PG8_MMA(0, 0, At, B0); PG8_MMA(0, 1, At, B1); PG8_BAR; PG8_SCHED;
            PG8_LDA(At, 0, 1); PG8_STAGE(PG8_SB(0, 0), b2, voffB); PG8_STAGE(PG8_SB(0, 1), b2 + hstepB, voffB); PG8_STAGE(PG8_SA(0, 0), a2, voffA);
            PG8_WAIT_V(8); PG8_WAIT_L(0); PG8_BAR; PG8_MMA(1, 0, At, B0); PG8_MMA(1, 1, At, B1); PG8_BAR; PG8_SCHED;
            PG8_LDB(B0, 1, 0); PG8_LDB(B1, 1, 1); PG8_SCHED; PG8_LDA(At, 1, 0); PG8_STAGE(PG8_SA(0, 1), a2 + hstepA, voffA);
            PG8_WAIT_V(8); PG8_WAIT_L(0); PG8_BAR; PG8_MMA(0, 0, At, B0); PG8_MMA(0, 1, At, B1); PG8_BAR; PG8_SCHED;
            PG8_LDA(At, 1, 1); PG8_STAGE(PG8_SB(1, 0), b3, voffB); PG8_STAGE(PG8_SB(1, 1), b3 + hstepB, voffB); PG8_STAGE(PG8_SA(1, 0), a3, voffA);
            PG8_WAIT_V(8); PG8_WAIT_L(0); PG8_BAR; PG8_MMA(1, 0, At, B0); PG8_MMA(1, 1, At, B1); PG8_BAR; PG8_SCHED;
            } else {
            PG8_LDB(B0, 0, 0); PG8_SCHED; PG8_LDA(At, 0, 0); PG8_STAGE(PG8_SA(1, 1), a1 + hstepA, voffA);
            PG8_WAIT_L(8); PG8_BAR; PG8_WAIT_L(0); PG8_MMA(0, 0, At, B0); PG8_BAR; PG8_SCHED;
            PG8_LDB(B1, 0, 1); PG8_STAGE(PG8_SB(0, 0), b2, voffB);
            PG8_BAR; PG8_WAIT_L(0); PG8_MMA(0, 1, At, B1); PG8_BAR;
            PG8_LDA(At, 0, 1); PG8_STAGE(PG8_SA(0, 0), a2, voffA);
            PG8_BAR; PG8_WAIT_L(0); PG8_MMA(1, 0, At, B0); PG8_BAR; PG8_SCHED;
            PG8_STAGE(PG8_SB(0, 1), b2 + hstepB, voffB);
            PG8_WAIT_V(6); PG8_BAR; PG8_MMA(1, 1, At, B1); PG8_BAR;
            PG8_LDB(B0, 1, 0); PG8_SCHED; PG8_LDA(At, 1, 0); PG8_STAGE(PG8_SA(0, 1), a2 + hstepA, voffA);
            PG8_WAIT_L(8); PG8_BAR; PG8_WAIT_L(0); PG8_MMA(0, 0, At, B0); PG8_BAR; PG8_SCHED;
            PG8_LDB(B1, 1, 1); PG8_STAGE(PG8_SB(1, 0), b3, voffB);
            PG8_BAR; PG8_WAIT_L(0); PG8_MMA(0, 1, At, B1); PG8_BAR;
            PG8_LDA(At, 1, 1); PG8_STAGE(PG8_SA(1, 0), a3, voffA);
            PG8_BAR; PG8_WAIT_L(0); PG8_MMA(1, 0, At, B0); PG8_BAR; PG8_SCHED;
            PG8_STAGE(PG8_SB(1, 1), b3 + hstepB, voffB);
            PG8_WAIT_V(6); PG8_BAR; PG8_MMA(1, 1, At, B1); PG8_BAR;
            }
        }
        if constexpr (ALIGN_EPI) { if (wr == 0) PG8_BAR; }
        if constexpr (epi_has_bias<Epi>) { if (has_next) E.load_bias(nxt, wc, fq, bnx); }
        if constexpr (!Epi::AFTER_DRAIN) { E(acc, cur, wr, wc, fr, fq); S.done(cur); }
        if (!has_next) break;
        if (!keep_acc_of(E, cur, 0)) {
#pragma unroll
        for (int a = 0; a < 2; ++a)
#pragma unroll
            for (int b = 0; b < 2; ++b)
#pragma unroll
                for (int m = 0; m < 4; ++m)
#pragma unroll
                    for (int n = 0; n < 2; ++n) { if constexpr (epi_has_bias<Epi>) acc[a][b][m][n] = bnx[b][n]; else acc[a][b][m][n] = (f32x4){0.f, 0.f, 0.f, 0.f}; }
        }
        cur = nxt; cA = nA; cB = nB; ++ui;
        if constexpr (ALIGN_EPI) { if (wr == 1) PG8_BAR; }
    }
    PG8_WAIT_V(0);
    if constexpr (!ALIGN_EPI) { if (wr == 0) PG8_BAR; }
    PG8_BAR;
    if constexpr (Epi::AFTER_DRAIN) { E.fused(acc, cur, wr, wc, fr, fq, lds, wid, lane); S.done(cur); }
#undef PG8_SA
#undef PG8_SB
#undef PG8_STAGE
#undef PG8_LDA
#undef PG8_LDB
#undef PG8_MMA
#undef PG8_WAIT_V
#undef PG8_WAIT_L
#undef PG8_BAR
#undef PG8_SCHED
}
}

#define LAS __attribute__((address_space(3)))
#define DI __device__ __forceinline__
using pg8::bf16_t; using pg8::pk2; using pg8::bflo; using pg8::bfhi; using pg8::silu_f;
using pg8::TOK; using pg8::DM; using pg8::NPAD;
typedef short bf16x8 __attribute__((ext_vector_type(8)));
typedef short s16x4 __attribute__((ext_vector_type(4)));
typedef short v4i16_t __attribute__((ext_vector_type(4)));
typedef float f32x16 __attribute__((ext_vector_type(16)));
typedef float f32x4 __attribute__((ext_vector_type(4)));
typedef unsigned u32x4 __attribute__((ext_vector_type(4)));
typedef unsigned u32x2 __attribute__((ext_vector_type(2)));
#define LDS_WAIT() asm volatile("s_waitcnt lgkmcnt(0)" ::: "memory")
DI float bf2f(bf16_t v) { return __uint_as_float((unsigned)v << 16); }
DI float wave_sum(float v) {
#pragma unroll
    for (int o = 1; o < 64; o <<= 1) v += __shfl_xor(v, o);
    return v;
}
DI float ex2(float v) { return __builtin_amdgcn_exp2f(v); }

DI int win_src_col(int n) {
    if (n < 5120) return n;
    if (n < 7168) return n + 48;
    if (n < 15360) { const int t = (n - 7168) >> 8, j = (n - 7168) & 255, hf = j >> 7, ch = 128 * (t & 15) + (j & 127); return (t < 16 ? (hf ? 9264 : 7216) : (hf ? 13360 : 11312)) + ch; }
    if (n < 19456) { const int t = (n - 15360) >> 8, j = (n - 15360) & 255; return 15408 + ((j >> 7) ? 2048 : 0) + 128 * t + (j & 127); }
    return n < 19504 ? n - 14336 : -1; }
DI void tr_item(const float* __restrict__ W, int Nsrc, int srccol4, bf16_t* WT, int Kdst, int n0dst, int k0, LAS float* scr, int lane) {
    const int c4 = 4 * (lane & 15);
    f32x4 v[16];
#pragma unroll
    for (int i = 0; i < 16; ++i) { v[i] = (f32x4){0.f, 0.f, 0.f, 0.f}; if (srccol4 >= 0) v[i] = __builtin_nontemporal_load((const f32x4*)(W + (size_t)(k0 + 4 * i + (lane >> 4)) * Nsrc + srccol4)); }
#pragma unroll
    for (int i = 0; i < 16; ++i) { LAS float* d = scr + (4 * i + (lane >> 4)) * 65 + c4; d[0] = v[i].x; d[1] = v[i].y; d[2] = v[i].z; d[3] = v[i].w; }
    LDS_WAIT();
    const int c = lane & 7;
#pragma unroll
    for (int x = 0; x < 8; ++x) { const int n = 8 * x + (lane >> 3); const LAS float* s = scr + (8 * c) * 65 + n;
        u32x4 o; o.x = pk2(s[0 * 65], s[1 * 65]); o.y = pk2(s[2 * 65], s[3 * 65]); o.z = pk2(s[4 * 65], s[5 * 65]); o.w = pk2(s[6 * 65], s[7 * 65]);
        *(u32x4*)(WT + (size_t)(n0dst + n) * Kdst + k0 + 8 * c) = o; }
    LDS_WAIT();
}
struct Args { const float* in[16]; float* out; unsigned char* ws; int ph_lo, ph_hi, ph_rep, pad; };

template <int PART>
DI void p0_phase(LAS unsigned char* lds, const Args& a, int fi, int nf, int tid, int lane, int wave) {
    unsigned char* ws = a.ws;
    LAS float* scr = (LAS float*)(lds + wave * 16640);
    const int gw = fi * 8 + wave, NGW = nf * 8;
    constexpr int I_WIN = 32 * 308, I_SQ = 32 * 32, I_W1 = 256;
    const int l4 = 4 * (lane & 15);
    if (PART == 0) {
        for (int r = gw; r < I_WIN; r += NGW) { const int kb = r & 31, nb = r >> 5;
            tr_item(a.in[2], 19504, win_src_col(nb * 64 + l4), (bf16_t*)(ws + pg8::WS_WIN), 2048, nb * 64, kb * 64, scr, lane); }
        for (int m = gw; m < TOK; m += NGW) {
            const f32x4* xr = (const f32x4*)(a.in[0] + (size_t)m * DM) + lane; const f32x4* gr = (const f32x4*)a.in[1] + lane;
            f32x4 v[8]; float s = 0.f;
#pragma unroll
            for (int j = 0; j < 8; ++j) { v[j] = __builtin_nontemporal_load(xr + 64 * j); s += (v[j].x * v[j].x + v[j].y * v[j].y) + (v[j].z * v[j].z + v[j].w * v[j].w); }
            const float rs = 1.0f / sqrtf(wave_sum(s) * (1.f / DM) + 1e-6f);
            u32x2* o8 = (u32x2*)((bf16_t*)(ws + pg8::WS_HN) + (size_t)m * DM) + lane;
#pragma unroll
            for (int j = 0; j < 8; ++j) { const f32x4 g = gr[64 * j]; u32x2 w; w.x = pk2(v[j].x * rs * g.x, v[j].y * rs * g.y); w.y = pk2(v[j].z * rs * g.z, v[j].w * rs * g.w); o8[64 * j] = w; }
        }
        { float* bp = (float*)(ws + pg8::WS_BIAS);
          for (int n = fi * 512 + tid; n < NPAD; n += nf * 512) { const int sc = win_src_col(n); bp[n] = sc >= 0 ? a.in[3][sc] : 0.f; } }
    } else {
        for (int r0 = gw; r0 < 3 * I_SQ + 2 * I_W1; r0 += NGW) { int r = r0;
            if (r < 3 * I_SQ) { const int w = r / I_SQ, r2 = r % I_SQ, kb = r2 & 31, nb = r2 >> 5;
                tr_item(a.in[12 + w], 2048, nb * 64 + l4, (bf16_t*)(ws + pg8::WS_PAT + (size_t)w * pg8::SZ_W), 2048, nb * 64, kb * 64, scr, lane); continue; }
            r -= 3 * I_SQ;
            { const int which = r / I_W1, r2 = r % I_W1, half = r2 / 128, r3 = r2 % 128, kb = r3 & 31, nb = r3 >> 5;
              tr_item(a.in[which ? 8 : 5] + (size_t)half * 2048 * 256, 256, nb * 64 + l4, (bf16_t*)(ws + (which ? pg8::WS_W1V : pg8::WS_W1K)), 2048, half * 256 + nb * 64, kb * 64, scr, lane); } }
        for (int job = fi * 2 + (tid >> 8); job < 64; job += nf * 2) { const int which = job >> 5, chunk = job & 31, j = tid & 255;
            const float* pe = a.in[which ? 7 : 4] + chunk * 128; const float* w1 = a.in[which ? 8 : 5] + (size_t)chunk * 128 * 256 + j; float s = 0.f;
#pragma unroll 32
            for (int r = 0; r < 128; ++r) s += pe[r] * w1[(size_t)r * 256];
            ((float*)(ws + pg8::WS_CPART))[(which * 32 + chunk) * 256 + j] = s; }
    }
}

DI void conv_run(unsigned char* ws, const float (&w0)[8], const float (&w1)[8], const float (&w2)[8], const float (&bb)[8], int run, int tid) {
    const int cg8 = tid & 255, t0 = run * 8, ch = cg8 * 8;
    const bf16_t* V = (const bf16_t*)(ws + pg8::WS_ZA + 1 * pg8::SZ_TD); const bf16_t* GT = (const bf16_t*)(ws + pg8::WS_ZA + 2 * pg8::SZ_TD);
    bf16_t* A2 = (bf16_t*)(ws + pg8::WS_A2);
    float v1[8], v2[8];
#pragma unroll
    for (int k = 0; k < 8; ++k) { v1[k] = 0.f; v2[k] = 0.f; }
    auto unpack = [](const u32x4 w, float (&f)[8]) { f[0] = bflo(w.x); f[1] = bfhi(w.x); f[2] = bflo(w.y); f[3] = bfhi(w.y); f[4] = bflo(w.z); f[5] = bfhi(w.z); f[6] = bflo(w.w); f[7] = bfhi(w.w); };
    u32x4 vv[8], gv[8];
#pragma unroll
    for (int tt = 0; tt < 8; ++tt) { const size_t o = (size_t)(t0 + tt) * DM + ch; vv[tt] = *(const u32x4*)(V + o); gv[tt] = __builtin_nontemporal_load((const u32x4*)(GT + o)); }
    if ((t0 & 2047) != 0) { unpack(*(const u32x4*)(V + (size_t)(t0 - 2) * DM + ch), v2); unpack(*(const u32x4*)(V + (size_t)(t0 - 1) * DM + ch), v1); }
#pragma unroll
    for (int tt = 0; tt < 8; ++tt) { const size_t o = (size_t)(t0 + tt) * DM + ch;
        float v[8], g[8], r[8];
        unpack(vv[tt], v); unpack(gv[tt], g);
#pragma unroll
        for (int k = 0; k < 8; ++k) { const float y = w0[k] * v2[k] + w1[k] * v1[k] + w2[k] * v[k] + bb[k]; r[k] = g[k] * y; v2[k] = v1[k]; v1[k] = v[k]; }
        u32x4 w; w.x = pk2(r[0], r[1]); w.y = pk2(r[2], r[3]); w.z = pk2(r[4], r[5]); w.w = pk2(r[6], r[7]);
        *(u32x4*)(A2 + o) = w; }
}

DI void p3_phase(LAS unsigned char* lds, unsigned char* ws, const float* w2k, const float* w2v, int bx, int G, int tid) {
    LAS float* cst = (LAS float*)lds;
    LAS float* hid = cst + 256;
    for (int item = bx; item < 256; item += G) {
        const int which = item >> 7, rem = item & 127, bg = rem >> 3, n0 = (rem & 7) * 16;
        if (tid < 256) cst[tid] = ((const float*)(ws + pg8::WS_PARK))[which * 256 + tid];
        __syncthreads();
        const bf16_t* PQ = (const bf16_t*)(ws + (which ? pg8::WS_PQV : pg8::WS_PQK));
#pragma unroll
        for (int x = 0; x < 8; ++x) { const int e = tid + 512 * x, r = e >> 8, j = e & 255, n = n0 + r; float hv = 0.f;
            if (n < 127) { float s = cst[j];
#pragma unroll
                for (int sp = 0; sp < 4; ++sp) s += bf2f(PQ[(size_t)sp * 2048 * 512 + (size_t)(bg * 128 + n) * 512 + j]) + bf2f(PQ[(size_t)sp * 2048 * 512 + (size_t)(bg * 128 + n + 1) * 512 + 256 + j]);
                hv = silu_f(s); }
            hid[j * 16 + r] = hv; }
        __syncthreads();
        const int d = tid & 127, rg = tid >> 7; const float* w2 = (which ? w2v : w2k) + d; f32x4 acc = {0.f, 0.f, 0.f, 0.f};
#pragma unroll 16
        for (int j = 0; j < 256; ++j) acc += *(const LAS f32x4*)(hid + j * 16 + 4 * rg) * w2[j * 128];
        bf16_t* ob = (bf16_t*)(ws + (which ? pg8::WS_VCB : pg8::WS_KCB)) + (size_t)(bg * 128 + n0 + 4 * rg) * 128 + d;
#pragma unroll
        for (int k = 0; k < 4; ++k) ob[k * 128] = (bf16_t)(pk2((n0 + 4 * rg + k) < 127 ? acc[k] : 0.f, 0.f) & 0xffffu);
        __syncthreads();
    }
}

DI void p8_phase(float* out, const float* fg, int vcu, int G, int lane, int wave) {
    for (int m = vcu * 8 + wave; m < TOK; m += G * 8) {
        f32x4* xr = (f32x4*)(out + (size_t)m * DM) + lane; const f32x4* gr = (const f32x4*)fg + lane;
        f32x4 v[8]; float s = 0.f;
#pragma unroll
        for (int j = 0; j < 8; ++j) { v[j] = xr[64 * j]; s += (v[j].x * v[j].x + v[j].y * v[j].y) + (v[j].z * v[j].z + v[j].w * v[j].w); }
        const float rs = 1.0f / sqrtf(wave_sum(s) * (1.f / DM) + 1e-6f);
#pragma unroll
        for (int j = 0; j < 8; ++j) xr[64 * j] = v[j] * rs * gr[64 * j];
    }
}
namespace att {
constexpr int KP = 272, VP = 320, KBUF = 64 * KP, VBUF = 64 * VP;
constexpr int L_K = 0, L_V = 2 * KBUF, L_IMPH = L_V + 2 * VBUF, L_IMP = L_IMPH + 4 * 64 * 33 * 4  , L_PARK = L_IMPH  , L_MASK = 146688, L_END = L_MASK + 256;
static_assert(L_IMP + 8192 <= L_PARK + 65536 && L_PARK + 65536 <= L_MASK, "attention LDS map");
constexpr float NEG = -1e30f;
DI float xhalf(float v) { const auto rr = __builtin_amdgcn_permlane32_swap(__float_as_uint(v), __float_as_uint(v), false, false); return __uint_as_float((threadIdx.x & 32) ? rr[0] : rr[1]); }
DI float fadd_s(float a, float b) { float r; asm("v_add_f32_e32 %0, %1, %2" : "=v"(r) : "v"(a), "v"(b)); return r; }
DI int crow(int i, int h) { return (i & 3) + 8 * (i >> 2) + 4 * h; }
#define MFMA32(a, b, c) __builtin_amdgcn_mfma_f32_32x32x16_bf16((a), (b), (c), 0, 0, 0)
DI s16x4 vtr(const LAS unsigned char* p) { return __builtin_bit_cast(s16x4, __builtin_amdgcn_ds_read_tr16_b64_v4i16((LAS v4i16_t*)p)); }
DI bf16x8 pack8(const f32x16& p, int s8) {
    u32x4 w; w.x = pk2(p[s8 + 0], p[s8 + 1]); w.y = pk2(p[s8 + 2], p[s8 + 3]); w.z = pk2(p[s8 + 4], p[s8 + 5]); w.w = pk2(p[s8 + 6], p[s8 + 7]); return __builtin_bit_cast(bf16x8, w); }
DI void pv_step(f32x16 (&o)[4], const LAS unsigned char* vb, const bf16x8 pk) {
#pragma unroll
    for (int d = 0; d < 4; ++d) { const s16x4 lo = vtr(vb + d * 64), hi = vtr(vb + d * 64 + 8 * VP);
        const bf16x8 vf = __builtin_shufflevector(lo, hi, 0, 1, 2, 3, 4, 5, 6, 7); o[d] = MFMA32(vf, pk, o[d]); }
    __builtin_amdgcn_sched_barrier(0);
}

DI void pv_nobar(f32x16 (&o)[4], const LAS unsigned char* vb, const bf16x8 pk) {
#pragma unroll
    for (int d = 0; d < 4; ++d) { const s16x4 lo = vtr(vb + d * 64), hi = vtr(vb + d * 64 + 8 * VP);
        const bf16x8 vf = __builtin_shufflevector(lo, hi, 0, 1, 2, 3, 4, 5, 6, 7); o[d] = MFMA32(vf, pk, o[d]); }
}
template <int BR>
DI void flash(LAS unsigned char* lds, const bf16_t* __restrict__ Kg, const bf16_t* __restrict__ Vg, int c, const bf16x8 (&q)[8], f32x16 (&o)[4], float& lsum, unsigned selmask, int tokoff, int lane, int tid, u32x4& fk0, u32x4& fk1, u32x4& fv0, u32x4& fv1, const bf16_t* __restrict__ Kn, const bf16_t* __restrict__ Vn, const char* zsrc, u32x4 (&z)[8]) {
    const int h = lane >> 5, r32 = lane & 31;
    const int jlo = (BR == 1) ? 0 : (c > 8 ? c - 8 : 0);
    const int ntiles = c - jlo + 1;
    const int key0 = tid >> 4, part = tid & 15;
    u32x4 r0, r1, r2, r3;
    const unsigned goff = (unsigned)tid * 16u;
    const unsigned kdo = (unsigned)(key0 * KP + part * 16), vdo = (unsigned)(key0 * VP + part * 16);
#define GLOADX(P, j) do { const char* p_ = (const char*)(P) + (size_t)(j) * 16384; r0 = *(const u32x4*)(p_ + goff); r1 = *(const u32x4*)(p_ + 8192 + goff); } while (0)
#define LSTOREK(buf) do { LAS unsigned char* d_ = lds + L_K + (buf) * KBUF + kdo; *(LAS u32x4*)d_ = r0; *(LAS u32x4*)(d_ + 32 * KP) = r1; } while (0)
#define GLOADV(P, j) do { const char* p_ = (const char*)(P) + (size_t)(j) * 16384; r2 = *(const u32x4*)(p_ + goff); r3 = *(const u32x4*)(p_ + 8192 + goff); } while (0)
#define LSTOREV(buf) do { LAS unsigned char* d_ = lds + L_V + (buf) * VBUF + vdo; *(LAS u32x4*)d_ = r2; *(LAS u32x4*)(d_ + 32 * VP) = r3; } while (0)
#define KRD(dst, kb_, pr) do { dst[0] = *(const LAS bf16x8*)((kb_) + (2 * (pr)) * 32); dst[1] = *(const LAS bf16x8*)((kb_) + 32 * KP + (2 * (pr)) * 32); \
        dst[2] = *(const LAS bf16x8*)((kb_) + (2 * (pr) + 1) * 32); dst[3] = *(const LAS bf16x8*)((kb_) + 32 * KP + (2 * (pr) + 1) * 32); } while (0)
#define KMM(src, pr) do { p0 = MFMA32(src[0], q[2 * (pr)], p0); p1 = MFMA32(src[1], q[2 * (pr)], p1); p0 = MFMA32(src[2], q[2 * (pr) + 1], p0); p1 = MFMA32(src[3], q[2 * (pr) + 1], p1); } while (0)
#define SB0() __builtin_amdgcn_sched_barrier(0)
#define QKT(buf) do { const LAS unsigned char* kb_ = lds + L_K + (buf) * KBUF + r32 * KP + h * 16; bf16x8 ka[4], kb2[4]; \
        KRD(ka, kb_, 0); SB0(); \
        KRD(kb2, kb_, 1); p0 = MFMA32(ka[0], q[0], cin); p1 = MFMA32(ka[1], q[0], cin); p0 = MFMA32(ka[2], q[1], p0); p1 = MFMA32(ka[3], q[1], p1); SB0(); \
        KRD(ka, kb_, 2); KMM(kb2, 1); SB0(); \
        KRD(kb2, kb_, 3); KMM(ka, 2); SB0(); \
        KMM(kb2, 3); SB0(); } while (0)
    const int vlane = (4 * h + ((lane & 15) >> 2)) * VP + ((lane >> 4) & 1) * 32 + (lane & 3) * 8;
    f32x16 p0, p1, cin; bf16x8 pk0, pk1, pk2_, pk3;
    float mref, l;
    const bool lagw = __builtin_amdgcn_readfirstlane(tid) >= 256;
    if (lagw) __builtin_amdgcn_s_setprio(1);
    r0 = fk0; r1 = fk1; LSTOREK(0); r2 = fv0; r3 = fv1; LSTOREV(0);
#pragma unroll
    for (int d = 0; d < 4; ++d)
#pragma unroll
        for (int i = 0; i < 16; ++i) o[d][i] = 0.f;
    __syncthreads();
    { const bool more = ntiles > 1;
      if (more) GLOADX(Kg, c - 1);
#pragma unroll
      for (int i = 0; i < 16; ++i) cin[i] = 0.f;
      QKT(0);
      float rm = NEG;
#pragma unroll
      for (int i = 0; i < 16; ++i) { const int k0 = crow(i, h), k1 = k0 + 32;
          p0[i] = (k0 <= tokoff) ? p0[i] : NEG; p1[i] = (k1 <= tokoff) ? p1[i] : NEG; rm = fmaxf(fmaxf(rm, p0[i]), p1[i]); }
      rm = fmaxf(rm, xhalf(rm));
      mref = rm; float rs = 0.f;
#pragma unroll
      for (int i = 0; i < 16; ++i) { p0[i] = ex2(p0[i] - rm); p1[i] = ex2(p1[i] - rm); rs += p0[i] + p1[i]; }
      l = rs;
      pk0 = pack8(p0, 0); pk1 = pack8(p0, 8); pk2_ = pack8(p1, 0); pk3 = pack8(p1, 8);
      if (BR == 2) {
#pragma unroll
          for (int i = 0; i < 16; ++i) cin[i] = -mref; }
      if (more) LSTOREK(1);
      __syncthreads(); }
#pragma clang loop unroll(disable)
    for (int t = 1; t < ntiles; ++t) {
        const int j = c - t, kbuf = t & 1;
        const bool more = (t + 1 < ntiles);
        if (more) GLOADX(Kg, j - 1);
        GLOADV(Vg, j);
        if (BR == 1) { const float ci = ((selmask >> j) & 1u) ? -mref : NEG;
#pragma unroll
            for (int i = 0; i < 16; ++i) cin[i] = ci; }
        QKT(kbuf);
        if (BR == 2 && j == c - 8) {
#pragma unroll
            for (int i = 0; i < 16; ++i) { const int k0 = crow(i, h), k1 = k0 + 32; p0[i] = (k0 > tokoff) ? p0[i] : NEG; p1[i] = (k1 > tokoff) ? p1[i] : NEG; }
        }
        SB0();
        float rs0 = 0.f, rs1 = 0.f;
        const LAS unsigned char* vb = lds + L_V + (kbuf ^ 1) * VBUF + vlane;
#define SMQ(k) do { _Pragma("unroll") for (int i = 4 * (k); i < 4 * (k) + 4; ++i) { p0[i] = ex2(p0[i]); p1[i] = ex2(p1[i]); rs0 = fadd_s(rs0, p0[i]); rs1 = fadd_s(rs1, p1[i]); } } while (0)
#define VRD(lo_, hi_, s_) do { _Pragma("unroll") for (int d = 0; d < 4; ++d) { lo_[d] = vtr(vb + (16 * (s_)) * VP + d * 64); hi_[d] = vtr(vb + (16 * (s_) + 8) * VP + d * 64); } } while (0)
#define VMM(lo_, hi_, pk_) do { _Pragma("unroll") for (int d = 0; d < 4; ++d) o[d] = MFMA32(__builtin_shufflevector(lo_[d], hi_[d], 0, 1, 2, 3, 4, 5, 6, 7), pk_, o[d]); } while (0)
        { s16x4 la[4], ha[4];
          VRD(la, ha, 0); SMQ(0); VMM(la, ha, pk0); SB0();
          VRD(la, ha, 1); SMQ(1); VMM(la, ha, pk1); SB0();
          VRD(la, ha, 2); SMQ(2); VMM(la, ha, pk2_); SB0();
          VRD(la, ha, 3); SMQ(3); VMM(la, ha, pk3); SB0(); }
#undef SMQ
        float rs = rs0 + rs1;
        if (__any(rs > 512.0f)) {
            float me = fmaxf(p0[0], p1[0]);
#pragma unroll
            for (int i = 1; i < 16; ++i) me = fmaxf(fmaxf(me, p0[i]), p1[i]);
            me = fmaxf(me, xhalf(me));
            const bool grow = me > 256.0f; const float delta = grow ? __builtin_amdgcn_logf(me) : 0.f, alpha = grow ? __builtin_amdgcn_rcpf(me) : 1.f; mref += delta; l *= alpha; rs *= alpha;
#pragma unroll
            for (int i = 0; i < 16; ++i) { p0[i] *= alpha; p1[i] *= alpha; }
#pragma unroll
            for (int d = 0; d < 4; ++d)
#pragma unroll
                for (int i = 0; i < 16; ++i) o[d][i] *= alpha;
            if (BR == 2) {
#pragma unroll
                for (int i = 0; i < 16; ++i) cin[i] = -mref; }
        }
        l += rs;
        pk0 = pack8(p0, 0); pk1 = pack8(p0, 8); pk2_ = pack8(p1, 0); pk3 = pack8(p1, 8);
        if (more) LSTOREK(kbuf ^ 1);
        LSTOREV(kbuf);
        __syncthreads();
    }
    if (BR == 2) {
#pragma unroll
        for (int x = 0; x < 8; ++x) z[x] = __builtin_nontemporal_load((const u32x4*)(zsrc + (size_t)x * (4 * 2048 * 2))); }
    if (Kn) { const char* p_ = (const char*)Kn + (size_t)c * 16384; fk0 = *(const u32x4*)(p_ + goff); fk1 = *(const u32x4*)(p_ + 8192 + goff); p_ = (const char*)Vn + (size_t)c * 16384; fv0 = *(const u32x4*)(p_ + goff); fv1 = *(const u32x4*)(p_ + 8192 + goff); }
    { const LAS unsigned char* vb = lds + L_V + ((ntiles - 1) & 1) * VBUF + vlane;
      pv_step(o, vb, pk0); pv_step(o, vb + 16 * VP, pk1); pv_step(o, vb + 32 * VP, pk2_); pv_step(o, vb + 48 * VP, pk3); }
    __syncthreads();
#undef GLOADX
#undef LSTOREK
#undef LSTOREV
#undef GLOADV
#undef QKT
#undef KRD
#undef KMM
#undef VRD
#undef VMM
#undef SB0
    if (lagw) __builtin_amdgcn_s_setprio(0);
    lsum = l + xhalf(l);
}

DI void attn_unit(LAS unsigned char* lds, unsigned char* ws, int bg, int c, int tid_in, int wave) {
    int tid = tid_in; asm volatile("" : "+v"(tid));
    const int lane = tid & 63;
    const int b = bg >> 2, g = bg & 3, h = lane >> 5, r32 = lane & 31, hh = wave >> 1, th = wave & 1, head = 4 * g + hh;
    const int tokoff = 32 * th + r32; const size_t trow = (size_t)b * 2048 + 64 * c + tokoff;
    bf16x8 q[8];
    { const bf16_t* qp = (const bf16_t*)(ws + pg8::WS_Q) + trow * 2048 + head * 128 + 8 * h;
#pragma unroll
      for (int ks = 0; ks < 8; ++ks) q[ks] = *(const bf16x8*)(qp + 16 * ks); }
    const bf16_t* gn = (const bf16_t*)(ws + pg8::WS_GN) + trow * 256 + head;
    const float g0 = bf2f(gn[0]), g1 = bf2f(gn[16]), g2 = bf2f(gn[32]);
#define PARKP(d, u) ((LAS u32x2*)(lds + L_PARK + wave * 8192 + ((d) * 4 + (u)) * 512 + lane * 8))
    const bf16_t* const KSg = (const bf16_t*)(ws + pg8::WS_KC + 2 * pg8::SZ_KV) + (size_t)bg * 2048 * 128; const bf16_t* const VSg = (const bf16_t*)(ws + pg8::WS_KC + 3 * pg8::SZ_KV) + (size_t)bg * 2048 * 128;
    const bf16_t* const KWg = (const bf16_t*)(ws + pg8::WS_KC + 4 * pg8::SZ_KV) + (size_t)bg * 2048 * 128; const bf16_t* const VWg = (const bf16_t*)(ws + pg8::WS_KC + 5 * pg8::SZ_KV) + (size_t)bg * 2048 * 128;
    u32x4 fk0, fk1, fv0, fv1;
    u32x4 z[8];
    const char* const ZAl = (const char*)(ws + pg8::WS_ZA) + (((size_t)b * 2048 + 64 * c + 32 * th) * 2048 + head * 128) * 2 + (unsigned)((lane >> 4) * 2048 + (lane & 15) * 8) * 2u;
    f32x16 o[4]; float g0s = 0.f;
#ifndef ATT_SKIP_CMP
    {
        const bf16_t* kc = (const bf16_t*)(ws + pg8::WS_KCB) + (size_t)bg * 128 * 128; const bf16_t* vc = (const bf16_t*)(ws + pg8::WS_VCB) + (size_t)bg * 128 * 128;
#pragma unroll
        for (int x = 0; x < 4; ++x) { const int ch = tid + 512 * x, key = ch >> 4, part = ch & 15;
            *(LAS u32x4*)(lds + L_K + key * KP + part * 16) = *(const u32x4*)(kc + key * 128 + part * 8);
            *(LAS u32x4*)(lds + L_V + key * VP + part * 16) = *(const u32x4*)(vc + key * 128 + part * 8); }
        __syncthreads();
        f32x16 s[4];
        const int ntc = (4 * c + 3 + 31) >> 5;
        const int tok = 64 * c + tokoff; const int nvis = (tok >= 31) ? ((tok - 31) >> 4) + 1 : 0;
#pragma unroll
        for (int t = 0; t < 4; ++t)
#pragma unroll
            for (int i = 0; i < 16; ++i) s[t][i] = NEG;
#pragma unroll
        for (int tp = 0; tp < 2; ++tp) if (2 * tp < ntc) {
            f32x16 a0, a1;
#pragma unroll
            for (int i = 0; i < 16; ++i) { a0[i] = 0.f; a1[i] = 0.f; }
            const LAS unsigned char* kb = lds + L_K + (64 * tp + r32) * KP + h * 16;
#pragma unroll
            for (int ks = 0; ks < 8; ++ks) { a0 = MFMA32(*(const LAS bf16x8*)(kb + ks * 32), q[ks], a0); a1 = MFMA32(*(const LAS bf16x8*)(kb + 32 * KP + ks * 32), q[ks], a1); if (ks & 1) __builtin_amdgcn_sched_barrier(0); }
            if (64 * tp + 64 > 4 * c - 1) {
#pragma unroll
                for (int i = 0; i < 16; ++i) { const int n = 64 * tp + crow(i, h); a0[i] = (n < nvis) ? a0[i] : NEG; a1[i] = (n + 32 < nvis) ? a1[i] : NEG; }
            }
            s[2 * tp] = a0; s[2 * tp + 1] = a1;
        }
        float m = NEG;
#pragma unroll
        for (int t = 0; t < 4; ++t)
#pragma unroll
            for (int i = 0; i < 16; ++i) m = fmaxf(m, s[t][i]);
        m = fmaxf(m, xhalf(m));
        float l = 0.f;
#pragma unroll
        for (int t = 0; t < 4; ++t)
#pragma unroll
            for (int i = 0; i < 16; ++i) { s[t][i] = ex2(s[t][i] - m); l += s[t][i]; }
        l += xhalf(l);
        const float inv = (nvis > 0) ? 1.0f / l : 0.f;
        LAS float* impH = (LAS float*)(lds + L_IMPH) + (hh * 64 + tokoff) * 33;
#pragma unroll
        for (int t = 0; t < 4; ++t)
#pragma unroll
            for (int u = 0; u < 4; ++u) {
                const float bown = 0.5f * s[t][4 * u + 3];
                float bprev = 0.f; if (u > 0) bprev = 0.5f * s[t][4 * u - 1]; else if (t > 0) bprev = 0.5f * s[t - 1][15];
                const float send = h ? bprev : bown;
                const float recv = xhalf(send);
                const float a = s[t][4 * u] + s[t][4 * u + 1] + s[t][4 * u + 2] + bown;
                impH[8 * t + 2 * u + h] = (a + recv) * inv;
            }
#pragma unroll
        for (int d = 0; d < 4; ++d)
#pragma unroll
            for (int i = 0; i < 16; ++i) o[d][i] = 0.f;
        const LAS unsigned char* vb = lds + L_V + (4 * h + ((lane & 15) >> 2)) * VP + ((lane >> 4) & 1) * 32 + (lane & 3) * 8;
#pragma unroll
        for (int t = 0; t < 4; ++t) if (t < ntc) { pv_step(o, vb + (32 * t) * VP, pack8(s[t], 0)); pv_step(o, vb + (32 * t + 16) * VP, pack8(s[t], 8)); }
        g0s = g0 * inv;
        { const char* p_ = (const char*)KSg + (size_t)c * 16384 + (unsigned)tid * 16u; fk0 = *(const u32x4*)p_; fk1 = *(const u32x4*)(p_ + 8192);
          p_ = (const char*)VSg + (size_t)c * 16384 + (unsigned)tid * 16u; fv0 = *(const u32x4*)p_; fv1 = *(const u32x4*)(p_ + 8192); }
        __syncthreads();
        { LAS float* IH = (LAS float*)(lds + L_IMPH); LAS unsigned* IM = (LAS unsigned*)(lds + L_IMP);
#pragma unroll
          for (int x = 0; x < 4; ++x) { const int e = tid + 512 * x, j = e & 31;
              const int ei = (e >> 5) * 33 + j;
              float v = ((IH[ei] + IH[64 * 33 + ei]) + IH[2 * 64 * 33 + ei]) + IH[3 * 64 * 33 + ei];
              const bool causal = j <= c, forced = (j == 0 || j == c || j == c - 1);
              v = forced ? 1e4f : v;
              IM[e] = causal ? ((__float_as_uint(v) & ~31u) | (unsigned)(31 - j)) : 0u; }
          __syncthreads();
          LAS unsigned* MK = (LAS unsigned*)(lds + L_MASK);
#pragma unroll
          for (int x = 0; x < 4; ++x) { const int e = tid + 512 * x, tk = e >> 5, j = e & 31; const unsigned v = IM[e]; int cnt = 0;
#pragma unroll
              for (int i4 = 0; i4 < 8; ++i4) { const u32x4 w = *(const LAS u32x4*)(IM + tk * 32 + 4 * i4);
                  cnt += (w.x > v) + (w.y > v) + (w.z > v) + (w.w > v); }
              const unsigned long long bal = __ballot(cnt < 8 && j <= c);
              if ((lane & 31) == 0) MK[tk] = (unsigned)(bal >> (lane & 32)); }
          __syncthreads(); }
    }
#endif
    const unsigned selmask = ((const LAS unsigned*)(lds + L_MASK))[tokoff];
#pragma unroll
    for (int d = 0; d < 4; ++d)
#pragma unroll
        for (int u = 0; u < 4; ++u) { u32x2 w; w.x = pk2(o[d][4 * u] * g0s, o[d][4 * u + 1] * g0s); w.y = pk2(o[d][4 * u + 2] * g0s, o[d][4 * u + 3] * g0s); *PARKP(d, u) = w; }
    float lsum = 1.f;
#ifndef ATT_SKIP_SEL
    flash<1>(lds, KSg, VSg, c, q, o, lsum, selmask, tokoff, lane, tid, fk0, fk1, fv0, fv1, KWg, VWg, (const char*)nullptr, z);
#endif
    { const float sc = g1 / lsum;
#pragma unroll
      for (int d = 0; d < 4; ++d)
#pragma unroll
          for (int u = 0; u < 4; ++u) { const u32x2 pw = *PARKP(d, u); u32x2 w;
              w.x = pk2(bflo(pw.x) + o[d][4 * u] * sc, bfhi(pw.x) + o[d][4 * u + 1] * sc); w.y = pk2(bflo(pw.y) + o[d][4 * u + 2] * sc, bfhi(pw.y) + o[d][4 * u + 3] * sc); *PARKP(d, u) = w; } }
#ifndef ATT_SKIP_WIN
    flash<2>(lds, KWg, VWg, c, q, o, lsum, 0u, tokoff, lane, tid, fk0, fk1, fv0, fv1, (const bf16_t*)nullptr, (const bf16_t*)nullptr, ZAl, z);
#endif
    { const float sc = g2 / lsum; LAS unsigned char* stg = lds + wave * (32 * 272);
      const size_t ub = (((size_t)b * 2048 + 64 * c + 32 * th) * 2048 + head * 128) * 2;
      const char* ZA = (const char*)(ws + pg8::WS_ZA) + ub; char* A1 = (char*)(ws + pg8::WS_A1) + ub;
      const unsigned lo_ = (unsigned)((lane >> 4) * 2048 + (lane & 15) * 8) * 2u;
#pragma unroll
      for (int d = 0; d < 4; ++d)
#pragma unroll
          for (int u = 0; u < 4; ++u) { const u32x2 pw = *PARKP(d, u); u32x2 w;
              w.x = pk2(bflo(pw.x) + o[d][4 * u] * sc, bfhi(pw.x) + o[d][4 * u + 1] * sc); w.y = pk2(bflo(pw.y) + o[d][4 * u + 2] * sc, bfhi(pw.y) + o[d][4 * u + 3] * sc);
              *(LAS u32x2*)(stg + r32 * 272 + (32 * d + 8 * u + 4 * h) * 2) = w; }
      LDS_WAIT();
#pragma unroll
      for (int x = 0; x < 8; ++x) { const int idx = x * 64 + lane, row = idx >> 4, pt = idx & 15; const u32x4 v = *(const LAS u32x4*)(stg + row * 272 + pt * 16);
          const size_t go = (size_t)x * (4 * 2048 * 2) + lo_;
          u32x4 w; w.x = pk2(bflo(v.x) * bflo(z[x].x), bfhi(v.x) * bfhi(z[x].x)); w.y = pk2(bflo(v.y) * bflo(z[x].y), bfhi(v.y) * bfhi(z[x].y));
          w.z = pk2(bflo(v.z) * bflo(z[x].z), bfhi(v.z) * bfhi(z[x].z)); w.w = pk2(bflo(v.w) * bflo(z[x].w), bfhi(v.w) * bfhi(z[x].w));
          *(u32x4*)(A1 + go) = w; }
    }
#undef PARKP
    __syncthreads();
}
}
#define XB_TMO      128
#define XB_XCNT(j)  (256  + 64 * (j))
#define XB_XSUB(j)  (1280 + 64 * (j))
#define XB_XGEN(j)  (2304 + 64 * (j))
#define XB_TOP      3328
#define XB_TOPGEN   3392
#define XCD_BAR_WORDS 3456
#define XB_SPIN_CAP (1u << 18)

__device__ __forceinline__ unsigned xb_ld(unsigned* p)              { return __hip_atomic_load(p, __ATOMIC_RELAXED, __HIP_MEMORY_SCOPE_AGENT); }
__device__ __forceinline__ unsigned xb_add(unsigned* p, unsigned v) { return __hip_atomic_fetch_add(p, v, __ATOMIC_RELAXED, __HIP_MEMORY_SCOPE_AGENT); }
__device__ __forceinline__ unsigned xb_xcc_id() { return (unsigned)__builtin_amdgcn_s_getreg((3 << 11) | 20) & 0xFu; }
#define XB_SPIN(cond, bar) do { unsigned _sp = 0; while (cond) { __builtin_amdgcn_s_sleep(1); \
    if ((++_sp & 255u) == 0u) { if (xb_ld(&(bar)[XB_TMO])) break; if (_sp > XB_SPIN_CAP) { atomicAdd(&(bar)[XB_TMO], 1u); break; } } } } while (0)

struct XcdBarrier {
    unsigned* bar; unsigned x;
    volatile LAS unsigned* st;
};

__device__ __forceinline__ XcdBarrier xcd_barrier_post(unsigned* bar, volatile LAS unsigned* st) {
    XcdBarrier b; b.bar = bar; b.x = xb_xcc_id(); b.st = st;
    if (threadIdx.x == 0) (void)xb_add(&bar[XB_XCNT(b.x)], 1u);
    return b;
}
__device__ __forceinline__ void xcd_barrier_complete(unsigned* bar, unsigned x, unsigned& nloc, unsigned& nx) {
    const unsigned G = gridDim.x * gridDim.y * gridDim.z;
    unsigned sum, cnt, mine, sp = 0u;
    for (;;) {
        sum = 0u; cnt = 0u; mine = 0u;
#pragma unroll
        for (unsigned j = 0; j < 16; ++j) { const unsigned c = xb_ld(&bar[XB_XCNT(j)]); sum += c; cnt += (c > 0u) ? 1u : 0u; mine = (j == x) ? c : mine; }
        if (sum == G) break;
        __builtin_amdgcn_s_sleep(1);
        if ((++sp & 255u) == 0u) { if (xb_ld(&bar[XB_TMO])) break; if (sp > XB_SPIN_CAP) { atomicAdd(&bar[XB_TMO], 1u); break; } }
    }
    nloc = mine > 0u ? mine : 1u; nx = cnt > 0u ? cnt : 1u;
}

__device__ __forceinline__ void xcd_barrier_protocol(const XcdBarrier& b) {
        unsigned* bar = b.bar;
        __builtin_amdgcn_s_waitcnt(0);
        unsigned nloc = b.st[0], nx = b.st[1];
        if (nloc == 0u) { xcd_barrier_complete(bar, b.x, nloc, nx); b.st[0] = nloc; b.st[1] = nx; }
        const unsigned old = xb_add(&bar[XB_XSUB(b.x)], 1u);
        const unsigned gen = old / nloc;
        if (old + 1u == (gen + 1u) * nloc) {
            __builtin_amdgcn_fence(__ATOMIC_RELEASE, "agent");
            asm volatile("s_waitcnt vmcnt(0)" ::: "memory");
            const unsigned og = xb_add(&bar[XB_TOP], 1u);
            const unsigned tg = og / nx;
            if (og + 1u == (tg + 1u) * nx) xb_add(&bar[XB_TOPGEN], 1u);
            else XB_SPIN(xb_ld(&bar[XB_TOPGEN]) == tg, bar);
            __builtin_amdgcn_fence(__ATOMIC_ACQUIRE, "agent");
            xb_add(&bar[XB_XGEN(b.x)], 1u);
            asm volatile("s_waitcnt vmcnt(0)" ::: "memory");
        } else {
            XB_SPIN(xb_ld(&bar[XB_XGEN(b.x)]) == gen, bar);
            __builtin_amdgcn_fence(__ATOMIC_ACQUIRE, "agent");
            asm volatile("s_waitcnt vmcnt(0)" ::: "memory");
        }
}
__device__ __forceinline__ void xcd_barrier(const XcdBarrier& b) {
    asm volatile("s_waitcnt vmcnt(0)" ::: "memory");
    __syncthreads();
    if (threadIdx.x == 0) xcd_barrier_protocol(b);
    __syncthreads();
}

#ifndef MK_N_LAUNCHES
#define MK_N_LAUNCHES 1
#endif
constexpr int N_PHASES = 8;
#ifndef GEMM_REP_MASK
#define GEMM_REP_MASK 0
#endif
template <int SHIFT> struct RepOrder : pg8::StaticOrder {
    __device__ bool next(int i, pg8::Unit& u) const { return pg8::StaticOrder::next(i >> SHIFT, u); }
};
struct RevOrder : pg8::StaticOrder {
    __device__ bool next(int i, pg8::Unit& u) const { if (!pg8::StaticOrder::next(i, u)) return false; u.pn = nN - 1 - u.pn; return true; }
};
#define GREP(k) (((GEMM_REP_MASK) >> (k)) & 1)
struct ChainOrder : pg8::StaticOrder {
    __device__ bool next(int i, pg8::Unit& u) const { if (!pg8::StaticOrder::next(i >> 1, u)) return false; if (i & 1) { u.pm += 32; u.pn += 8; } return true; }
};
struct TwiceOrder : pg8::StaticOrder {
    __device__ bool next(int i, pg8::Unit& u) const { const int cnt = (nwg - c + G - 1) / G; return i < cnt ? pg8::StaticOrder::next(i, u) : (i < 2 * cnt ? pg8::StaticOrder::next(i - cnt, u) : false); }
};
constexpr int LDS_BYTES = 147456;
static_assert(att::L_END <= 146944 && pg8::STAGE_BYTES <= 131072, "LDS map");

__global__ void __launch_bounds__(512, 2) nsa_hybrid_fwd(Args a) {
    extern __shared__ __attribute__((aligned(16))) unsigned char lds_raw[];
    LAS unsigned char* lds = (LAS unsigned char*)lds_raw;
    for (int u = threadIdx.x; u < 128; u += 512) ((LAS unsigned*)(lds + 146944))[u] = 0u;
    __syncthreads();
    XcdBarrier bar = xcd_barrier_post((unsigned*)(a.ws + pg8::WS_CTL), (volatile LAS unsigned*)(lds + 146944 + 32));
    const int tid = threadIdx.x, lane = tid & 63, wave = __builtin_amdgcn_readfirstlane(tid >> 6);
    const int G = gridDim.x, bx = blockIdx.x;
    const int vcu = (G % 8 == 0) ? (bx % 8) * (G / 8) + bx / 8 : bx;
    unsigned char* ws = a.ws;
    const int lo = a.ph_lo, hi = a.ph_hi;
#ifndef PHASE_MASK
#define PHASE_MASK 0x1ff
#endif
#define IN(k) (((PHASE_MASK >> (k)) & 1) && lo <= (k) && (k) < hi)
#ifndef REPEAT_MASK
#define REPEAT_MASK 0
#endif
#define REPS(k) _Pragma("clang loop unroll(disable)") for (int rep_ = 0; rep_ < ((((REPEAT_MASK) >> (k)) & 1) ? a.ph_rep : 1); ++rep_)
#define SEAM(k) do { if (IN(k) && IN((k) + 1)) xcd_barrier(bar); } while (0)

    if (IN(0)) REPS(0) p0_phase<0>(lds, a, vcu, G, tid, lane, wave);
    SEAM(0);
    if (IN(1)) REPS(1) {
        pg8::Gemm g{(const bf16_t*)(ws + pg8::WS_HN), (const bf16_t*)(ws + pg8::WS_WIN), TOK, NPAD, DM}; RevOrder S; S.init(TOK, NPAD, G, bx);
        pg8::EpiIn E{ws, (const float*)(ws + pg8::WS_BIAS)};
        pg8::gemm_phase<pg8::EpiIn, RevOrder, true, true>(lds, g, S, E);
        { const int nfull = (77 * 32) % G; if (nfull != 0 && bx >= nfull) p0_phase<1>(lds, a, bx - nfull, G - nfull, tid, lane, wave); else if (nfull == 0) p0_phase<1>(lds, a, bx, G, tid, lane, wave); }
    }
    SEAM(1);
    if (IN(2)) REPS(2) {
        const int jb = bx >> 4, which = (jb >> 2) & 1, sp = jb & 3; const bool gj = bx < 128;
        { pg8::Gemm g{(const bf16_t*)(ws + pg8::WS_KC + (size_t)which * pg8::SZ_KV) + sp * 512, (const bf16_t*)(ws + (which ? pg8::WS_W1V : pg8::WS_W1K)) + sp * 512, 2048, 512, 512, 2048, 2048};
          RepOrder<GREP(2)> S; S.init(2048, 512, G, gj ? (bx & 15) : 16);
          pg8::EpiPlain E{(bf16_t*)(ws + (which ? pg8::WS_PQV : pg8::WS_PQK)) + (size_t)sp * 2048 * 512, 512}; pg8::gemm_phase<pg8::EpiPlain, RepOrder<GREP(2)>, true, true>(lds, g, S, E); }
        { const int hb = tid >> 8, ch = (tid & 255) * 8; float w0[8], w1[8], w2[8], bb[8];
#pragma unroll
          for (int k = 0; k < 8; ++k) { w0[k] = a.in[10][ch + k]; w1[k] = a.in[10][2048 + ch + k]; w2[k] = a.in[10][4096 + ch + k]; bb[k] = a.in[11][ch + k]; }
          if (gj) conv_run(ws, w0, w1, w2, bb, 768 + 2 * bx + hb, tid);
          else {
#pragma unroll 1
              for (int r = 0; r < 3; ++r) conv_run(ws, w0, w1, w2, bb, 6 * (bx - 128) + 2 * r + hb, tid); } }
        if (bx == G - 1) ((float*)(ws + pg8::WS_PARK))[tid] = [&]() { const float* cp = (const float*)(ws + pg8::WS_CPART) + (tid >> 8) * 32 * 256 + (tid & 255); float s = 0.f; for (int k = 0; k < 32; ++k) s += cp[k * 256]; return s; }();
    }
    SEAM(2);
    if (IN(3)) REPS(3) p3_phase(lds, ws, a.in[6], a.in[9], bx, G, tid);
    SEAM(3);
    if (IN(4)) REPS(4) {
        for (int pidx = vcu; pidx < 256; pidx += G) { const int bg = pidx >> 4, s = pidx & 15;
#pragma unroll 1
            for (int u2 = 0; u2 < 2; ++u2) att::attn_unit(lds, ws, bg, u2 ? s : 31 - s, tid, wave); }
    }
    SEAM(4);
    if (IN(5)) {
        pg8::Gemm g{(const bf16_t*)(ws + pg8::WS_A1), (const bf16_t*)(ws + pg8::WS_PAT), TOK, DM, DM}; ChainOrder S; S.init(TOK, DM, G, bx);
        pg8::EpiYChain E{(bf16_t*)(ws + pg8::WS_Y), (const bf16_t*)(ws + pg8::WS_GM)};
        pg8::gemm_phase<pg8::EpiYChain, ChainOrder, true, true>(lds, g, S, E);
    }
    f32x4 xacc[2][2][4][2];
    { pg8::StaticOrder S7; S7.init(TOK, DM, G, bx); pg8::Unit u7; u7.pm = 0; u7.pn = 0; (void)S7.next(0, u7);
      const float* xl = a.in[0] + (size_t)(u7.pm * 256 + (wave >> 2) * 64 + (lane & 15)) * 2048 + u7.pn * 256 + (wave & 3) * 32 + 8 * (lane >> 4);
#define LDX() do { _Pragma("unroll") for (int ai = 0; ai < 2; ++ai) _Pragma("unroll") for (int bj = 0; bj < 2; ++bj) _Pragma("unroll") for (int m = 0; m < 4; ++m) _Pragma("unroll") for (int n = 0; n < 2; ++n) \
          xacc[ai][bj][m][n] = __builtin_nontemporal_load((const f32x4*)(xl + (size_t)(ai * 128 + m * 16) * 2048 + bj * 128 + 4 * n)); } while (0)
      if (IN(6) && IN(7)) {
          asm volatile("s_waitcnt vmcnt(0)" ::: "memory"); __syncthreads();
          if (threadIdx.x != 0) LDX();
          if (threadIdx.x == 0) { xcd_barrier_protocol(bar); LDX(); }
          __syncthreads(); }
      else if (IN(7)) LDX();
#undef LDX
    }
    if (IN(7)) {
        pg8::Gemm g{(const bf16_t*)(ws + pg8::WS_Y), (const bf16_t*)(ws + pg8::WS_WOT), TOK, DM, DM}; pg8::StaticOrder S; S.init(TOK, DM, G, bx);
        pg8::EpiOutNorm E{a.in[0], a.out, a.in[15], (float*)(ws + pg8::WS_SLOTS), (unsigned*)(ws + pg8::WS_CTL) + pg8::CW_PANEL};
        pg8::gemm_phase<pg8::EpiOutNorm, pg8::StaticOrder, false, true>(lds, g, S, E, xacc);
    }
#undef IN
#undef SEAM
}

extern "C" void kernel_launch(void* const* d_in, const int* in_sizes, int n_in, void* d_out, int out_size, void* d_ws, size_t ws_size, hipStream_t stream) {
    static int grid = 0;
    if (grid == 0) {
        if (n_in != 16 || out_size != TOK * DM || ws_size < pg8::WS_END) { fprintf(stderr, "kernel_launch: unexpected shapes (n_in %d, out %d, ws %zu < %zu)\n", n_in, out_size, ws_size, (size_t)pg8::WS_END); grid = -1; return; }
        int dev = 0, cus = 0, per_cu = 0;
        (void)hipGetDevice(&dev); (void)hipDeviceGetAttribute(&cus, hipDeviceAttributeMultiprocessorCount, dev);
        (void)hipFuncSetAttribute((const void*)nsa_hybrid_fwd, hipFuncAttributeMaxDynamicSharedMemorySize, LDS_BYTES);
        (void)hipOccupancyMaxActiveBlocksPerMultiprocessor(&per_cu, (const void*)nsa_hybrid_fwd, 512, LDS_BYTES);
        if (per_cu < 1) { fprintf(stderr, "kernel_launch: occupancy query says %d blocks/CU\n", per_cu); per_cu = 1; }
        grid = cus * per_cu; if (grid > 256) grid = 256;
        if (grid != 256) { fprintf(stderr, "kernel_launch: this kernel needs 256 resident workgroups (got %d)\n", grid); grid = -1; return; }
    }
    if (grid < 0) return;
    (void)hipMemsetAsync((char*)d_ws + pg8::WS_CTL, 0, 65536, stream);
    Args a{};
    for (int i = 0; i < 16; ++i) a.in[i] = (const float*)d_in[i];
    a.out = (float*)d_out; a.ws = (unsigned char*)d_ws; a.ph_rep = 2;
#if MK_N_LAUNCHES == 1
    a.ph_lo = 0; a.ph_hi = N_PHASES;
    { void* args[] = {&a}; hipError_t e = hipLaunchCooperativeKernel((const void*)nsa_hybrid_fwd, dim3(grid), dim3(512), args, LDS_BYTES, stream);
      if (e != hipSuccess) fprintf(stderr, "cooperative launch failed: %s (grid %d)\n", hipGetErrorString(e), grid); }
#else
    for (int p = 0; p < N_PHASES; ++p) { a.ph_lo = p; a.ph_hi = p + 1;
        hipLaunchKernelGGL(nsa_hybrid_fwd, dim3(grid), dim3(512), LDS_BYTES, stream, a); }
#endif
}
```
